# Optimizing an MI355X kernel written in HIP

```python
import math
import jax, jax.numpy as jnp
from jax import lax
import numpy as np

D_MODEL = 1024
BATCH = 16
SEQ = 4096
DEPTH = 1

GRID_W = 64
CTX_LEN = 256
N_HEADS = 8
HEAD_DIM = 64
V_DIM = 2 * HEAD_DIM
ATTN_WIDTH = N_HEADS * V_DIM
S5_WIDTH = D_MODEL // 2
S5_GROUP = 16
S5_GROUPS = S5_WIDTH // S5_GROUP
S5_STATE = 64
D_FF = ((8 * D_MODEL // 3 + 127) // 128) * 128
N_MOD = 9
ROPE_BASE = 10000.0
Q_BLOCK = 128
EPS = 1e-6
DT_MIN = 1e-3
DT_MAX = 1e-1
Q_COLS = N_HEADS * 2 * HEAD_DIM
K_COLS = N_HEADS * 2 * HEAD_DIM
V_COLS = N_HEADS * V_DIM
U_COLS = S5_WIDTH
IN_COLS = Q_COLS + K_COLS + V_COLS + U_COLS + 2 * D_MODEL
SPLIT_POINTS = (Q_COLS, Q_COLS + K_COLS, Q_COLS + K_COLS + V_COLS,
                Q_COLS + K_COLS + V_COLS + U_COLS,
                Q_COLS + K_COLS + V_COLS + U_COLS + D_MODEL)

kernel_name = "hybrid_diffattn_s5_macaron_block"


def rms_norm(x, g):
    xf = x.astype(jnp.float32)
    y = xf * lax.rsqrt(jnp.mean(xf * xf, axis=-1, keepdims=True) + EPS)
    return (y * g.astype(jnp.float32)).astype(x.dtype)


def modulate(x, g, shift, scale):
    return rms_norm(x, g) * (1.0 + scale) + shift


def swiglu(h, w13, w2):
    a, b = jnp.split(h @ w13, 2, axis=-1)
    return (jax.nn.silu(a) * b) @ w2


def split_proj(p):
    B, L, _ = p.shape
    q, k, v, u, ga, gs = jnp.split(p, SPLIT_POINTS, axis=-1)
    q = q.reshape(B, L, N_HEADS, 2, HEAD_DIM)
    k = k.reshape(B, L, N_HEADS, 2, HEAD_DIM)
    v = v.reshape(B, L, N_HEADS, V_DIM)
    return q, k, v, u, ga, gs


def axial_rope_tables(rows):
    n_freq = HEAD_DIM // 4
    inv = ROPE_BASE ** (-jnp.arange(n_freq, dtype=jnp.float32) / n_freq)
    row = jnp.repeat(jnp.arange(rows, dtype=jnp.float32), GRID_W)
    col = jnp.tile(jnp.arange(GRID_W, dtype=jnp.float32), rows)
    ang = jnp.concatenate([row[:, None] * inv, col[:, None] * inv], axis=-1)
    return jnp.cos(ang), jnp.sin(ang)


def apply_rope(t, cos, sin):
    half = HEAD_DIM // 2
    tf = t.astype(jnp.float32)
    t1, t2 = tf[..., :half], tf[..., half:]
    cs = cos[None, :, None, None, :]
    sn = sin[None, :, None, None, :]
    return jnp.concatenate([t1 * cs - t2 * sn, t2 * cs + t1 * sn], axis=-1).astype(t.dtype)


def diff_lambda(lq1, lk1, lq2, lk2, lam_init):
    f = lambda a: a.astype(jnp.float32)
    return jnp.exp(jnp.sum(f(lq1) * f(lk1))) - jnp.exp(jnp.sum(f(lq2) * f(lk2))) + lam_init


def diff_attend(q, k, v, lam):
    s = jnp.einsum('bqhid,bkhid->bhiqk', q, k,
                   preferred_element_type=jnp.float32) / math.sqrt(HEAD_DIM)
    p = jax.nn.softmax(s, axis=-1)
    a = p[:, :, 0] - lam * p[:, :, 1]
    return jnp.einsum('bhqk,bkhe->bqhe', a.astype(v.dtype), v)


def diff_attend_blocked(q, k, v, lam):
    B, L = q.shape[:2]
    nb = L // Q_BLOCK
    qb = jnp.moveaxis(q.reshape(B, nb, Q_BLOCK, N_HEADS, 2, HEAD_DIM), 1, 0)
    ob = lax.map(lambda qq: diff_attend(qq, k, v, lam), qb)
    return jnp.moveaxis(ob, 0, 1).reshape(B, L, N_HEADS, V_DIM)


def s5_discretize(lam_re, lam_im, log_dt, b_re, b_im):
    dt = jnp.exp(log_dt)[:, None]
    mag = jnp.exp(lam_re * dt)
    ar = mag * jnp.cos(lam_im * dt)
    ai = mag * jnp.sin(lam_im * dt)
    den = lam_re * lam_re + lam_im * lam_im
    nr = ar - 1.0
    fr = (nr * lam_re + ai * lam_im) / den
    fi = (ai * lam_re - nr * lam_im) / den
    bbr = fr[..., None] * b_re - fi[..., None] * b_im
    bbi = fr[..., None] * b_im + fi[..., None] * b_re
    return ar, ai, bbr, bbi


def _lin_combine(left, right):
    ar_l, ai_l, br_l, bi_l = left
    ar_r, ai_r, br_r, bi_r = right
    ar = ar_r * ar_l - ai_r * ai_l
    ai = ar_r * ai_l + ai_r * ar_l
    br = ar_r * br_l - ai_r * bi_l + br_r
    bi = ar_r * bi_l + ai_r * br_l + bi_r
    return ar, ai, br, bi


def s5_scan(u, ar, ai, bbr, bbi, h0r, h0i):
    br = jnp.einsum('blgc,gpc->blgp', u, bbr)
    bi = jnp.einsum('blgc,gpc->blgp', u, bbi)
    br = br.at[:, 0].add(ar * h0r - ai * h0i)
    bi = bi.at[:, 0].add(ar * h0i + ai * h0r)
    L = u.shape[1]
    arL = jnp.broadcast_to(ar, (1, L) + ar.shape)
    aiL = jnp.broadcast_to(ai, (1, L) + ai.shape)
    _, _, hr, hi = lax.associative_scan(_lin_combine, (arL, aiL, br, bi), axis=1)
    return hr, hi


def s5_readout(hr, hi, c_re, c_im):
    return (jnp.einsum('gcp,blgp->blgc', c_re, hr)
            - jnp.einsum('gcp,blgp->blgc', c_im, hi))


def s5_output(y, u, d_skip, w_glu, b_glu, dtype):
    B, L = y.shape[:2]
    y = y.reshape(B, L, S5_WIDTH) + d_skip.astype(jnp.float32) * u.reshape(B, L, S5_WIDTH)
    y = jax.nn.gelu(y.astype(dtype))
    return y * jax.nn.sigmoid(y @ w_glu + b_glu)


def s5_branch(u_x, u_c, lam_re, lam_im, log_dt, b_re, b_im, c_re, c_im,
              d_skip, w_glu, b_glu, with_ctx):
    f32 = jnp.float32
    B = u_x.shape[0]
    gx = u_x.astype(f32).reshape(B, u_x.shape[1], S5_GROUPS, S5_GROUP)
    gc = u_c.astype(f32).reshape(B, u_c.shape[1], S5_GROUPS, S5_GROUP)
    zeros = jnp.zeros((B, S5_GROUPS, S5_STATE), f32)
    y_x = 0.0
    y_c = 0.0
    for d in range(2):
        rev = d == 1
        ar, ai, bbr, bbi = s5_discretize(lam_re[d].astype(f32), lam_im[d].astype(f32),
                                         log_dt[d].astype(f32), b_re[d].astype(f32),
                                         b_im[d].astype(f32))
        ux_d = jnp.flip(gx, axis=1) if rev else gx
        uc_d = jnp.flip(gc, axis=1) if rev else gc
        hcr, hci = s5_scan(uc_d, ar, ai, bbr, bbi, zeros, zeros)
        hxr, hxi = s5_scan(ux_d, ar, ai, bbr, bbi, hcr[:, -1], hci[:, -1])
        cr, ci = c_re[d].astype(f32), c_im[d].astype(f32)
        yx = s5_readout(hxr, hxi, cr, ci)
        y_x = y_x + (jnp.flip(yx, axis=1) if rev else yx)
        if with_ctx:
            yc = s5_readout(hcr, hci, cr, ci)
            y_c = y_c + (jnp.flip(yc, axis=1) if rev else yc)
    out_x = s5_output(y_x, gx, d_skip, w_glu, b_glu, u_x.dtype)
    out_c = s5_output(y_c, gc, d_skip, w_glu, b_glu, u_c.dtype) if with_ctx else None
    return out_x, out_c


def merge_branches(o_attn, o_s5, g_attn, g_s5, w_pa, w_ps, w_out):
    m = jax.nn.sigmoid(g_attn) * (o_attn @ w_pa) + jax.nn.sigmoid(g_s5) * (o_s5 @ w_ps)
    return m @ w_out


def setup_inputs(seed: int = 0) -> dict:
    key = jax.random.key(seed)
    ks = iter(jax.random.split(key, 48))
    f32 = jnp.float32
    nrm = lambda shape, s: s * jax.random.normal(next(ks), shape, f32)
    gain = lambda shape: 1.0 + 0.02 * jax.random.normal(next(ks), shape, f32)
    Lz = DEPTH
    s5_shape = (Lz, 2, S5_GROUPS, S5_STATE)
    return {
        "x": nrm((BATCH, SEQ, D_MODEL), 1.0),
        "c": nrm((BATCH, D_MODEL), 1.0),
        "ctx": nrm((BATCH, CTX_LEN, D_MODEL), 1.0),
        "c_ctx": nrm((D_MODEL,), 1.0),
        "w_mod": nrm((Lz, D_MODEL, N_MOD * D_MODEL), 0.5 * D_MODEL ** -0.5),
        "b_mod": nrm((Lz, N_MOD * D_MODEL), 0.02),
        "norm_ffn1": gain((Lz, D_MODEL)),
        "w13_ffn1": nrm((Lz, D_MODEL, 2 * D_FF), D_MODEL ** -0.5),
        "w2_ffn1": nrm((Lz, D_FF, D_MODEL), D_FF ** -0.5),
        "norm_mix": gain((Lz, D_MODEL)),
        "w_in": nrm((Lz, D_MODEL, IN_COLS), D_MODEL ** -0.5),
        "q_norm": gain((Lz, HEAD_DIM)),
        "k_norm": gain((Lz, HEAD_DIM)),
        "lam_q1": nrm((Lz, HEAD_DIM), 0.1),
        "lam_k1": nrm((Lz, HEAD_DIM), 0.1),
        "lam_q2": nrm((Lz, HEAD_DIM), 0.1),
        "lam_k2": nrm((Lz, HEAD_DIM), 0.1),
        "subln": gain((Lz, V_DIM)),
        "s5_lam_re": -0.5 + nrm(s5_shape, 0.01),
        "s5_lam_im": jnp.pi * jnp.arange(S5_STATE, dtype=f32) + nrm(s5_shape, 0.01),
        "s5_log_dt": jax.random.uniform(next(ks), (Lz, 2, S5_GROUPS), f32,
                                        minval=math.log(DT_MIN), maxval=math.log(DT_MAX)),
        "s5_b_re": nrm((Lz, 2, S5_GROUPS, S5_STATE, S5_GROUP), (2 * S5_GROUP) ** -0.5),
        "s5_b_im": nrm((Lz, 2, S5_GROUPS, S5_STATE, S5_GROUP), (2 * S5_GROUP) ** -0.5),
        "s5_c_re": nrm((Lz, 2, S5_GROUPS, S5_GROUP, S5_STATE), (2 * S5_STATE) ** -0.5),
        "s5_c_im": nrm((Lz, 2, S5_GROUPS, S5_GROUP, S5_STATE), (2 * S5_STATE) ** -0.5),
        "s5_d": nrm((Lz, S5_WIDTH), 0.5),
        "w_glu": nrm((Lz, S5_WIDTH, S5_WIDTH), S5_WIDTH ** -0.5),
        "b_glu": nrm((Lz, S5_WIDTH), 0.02),
        "w_pa": nrm((Lz, ATTN_WIDTH, D_MODEL), ATTN_WIDTH ** -0.5),
        "w_ps": nrm((Lz, S5_WIDTH, D_MODEL), S5_WIDTH ** -0.5),
        "w_out": nrm((Lz, D_MODEL, D_MODEL), D_MODEL ** -0.5),
        "norm_ffn2": gain((Lz, D_MODEL)),
        "w13_ffn2": nrm((Lz, D_MODEL, 2 * D_FF), D_MODEL ** -0.5),
        "w2_ffn2": nrm((Lz, D_FF, D_MODEL), D_FF ** -0.5),
    }


def reference(x, c, ctx, c_ctx, w_mod, b_mod, norm_ffn1, w13_ffn1, w2_ffn1, norm_mix,
              w_in, q_norm, k_norm, lam_q1, lam_k1, lam_q2, lam_k2, subln,
              s5_lam_re, s5_lam_im, s5_log_dt, s5_b_re, s5_b_im, s5_c_re, s5_c_im,
              s5_d, w_glu, b_glu, w_pa, w_ps, w_out, norm_ffn2, w13_ffn2, w2_ffn2):
    B, L, _ = x.shape
    rows = L // GRID_W
    cos, sin = axial_rope_tables(rows)
    Lc = ctx.shape[1]
    for l in range(DEPTH):
        last = l == DEPTH - 1
        lam_init = 0.8 - 0.6 * math.exp(-0.3 * l)
        mod_x = jnp.split((jax.nn.silu(c) @ w_mod[l] + b_mod[l])[:, None, :], N_MOD, axis=-1)
        mod_c = jnp.split((jax.nn.silu(c_ctx) @ w_mod[l] + b_mod[l])[None, None, :], N_MOD, axis=-1)
        shx1, scx1, gx1, shx2, scx2, gx2, shx3, scx3, gx3 = mod_x
        shc1, scc1, gc1, shc2, scc2, gc2, shc3, scc3, gc3 = mod_c

        x = x + 0.5 * gx1 * swiglu(modulate(x, norm_ffn1[l], shx1, scx1), w13_ffn1[l], w2_ffn1[l])
        ctx = ctx + 0.5 * gc1 * swiglu(modulate(ctx, norm_ffn1[l], shc1, scc1), w13_ffn1[l], w2_ffn1[l])

        qx, kx, vx, ux, gax, gsx = split_proj(modulate(x, norm_mix[l], shx2, scx2) @ w_in[l])
        qc, kc, vc, uc, gac, gsc = split_proj(modulate(ctx, norm_mix[l], shc2, scc2) @ w_in[l])

        qx = apply_rope(rms_norm(qx, q_norm[l]), cos, sin)
        kx = apply_rope(rms_norm(kx, k_norm[l]), cos, sin)
        qc = rms_norm(qc, q_norm[l])
        kc = rms_norm(kc, k_norm[l])
        lam = diff_lambda(lam_q1[l], lam_k1[l], lam_q2[l], lam_k2[l], lam_init)
        k_all = jnp.concatenate([kc, kx], axis=1)
        v_all = jnp.concatenate([vc, vx], axis=1)
        ox = diff_attend_blocked(qx, k_all, v_all, lam)
        ox = (rms_norm(ox, subln[l]) * (1.0 - lam_init)).reshape(B, L, ATTN_WIDTH)

        sx, s5c = s5_branch(ux, uc, s5_lam_re[l], s5_lam_im[l], s5_log_dt[l], s5_b_re[l],
                            s5_b_im[l], s5_c_re[l], s5_c_im[l], s5_d[l], w_glu[l], b_glu[l],
                            with_ctx=not last)
        x_mix = merge_branches(ox, sx, gax, gsx, w_pa[l], w_ps[l], w_out[l])
        if not last:
            oc = diff_attend(qc, kc, vc, lam)
            oc = (rms_norm(oc, subln[l]) * (1.0 - lam_init)).reshape(B, Lc, ATTN_WIDTH)
            ctx = ctx + gc2 * merge_branches(oc, s5c, gac, gsc, w_pa[l], w_ps[l], w_out[l])
        x = x + gx2 * x_mix

        x = x + 0.5 * gx3 * swiglu(modulate(x, norm_ffn2[l], shx3, scx3), w13_ffn2[l], w2_ffn2[l])
        if not last:
            ctx = ctx + 0.5 * gc3 * swiglu(modulate(ctx, norm_ffn2[l], shc3, scc3), w13_ffn2[l], w2_ffn2[l])
    return x
```

```cpp
#include <hip/hip_runtime.h>
#include <hip/hip_cooperative_groups.h>
#include <cstdio>
#include <cstdint>
namespace cg = cooperative_groups;

#define LAS __attribute__((address_space(3)))
typedef unsigned short bf16_t;
typedef short bf16x8 __attribute__((ext_vector_type(8)));
typedef float f32x4 __attribute__((ext_vector_type(4)));
typedef float f32x16 __attribute__((ext_vector_type(16)));
typedef unsigned u32x4 __attribute__((ext_vector_type(4)));
typedef unsigned u32x2 __attribute__((ext_vector_type(2)));

#define DBG_ATT 1
#define REPG 1
#define REP5 1
#ifndef MK_SPLIT
#define MK_SPLIT 0
#endif

constexpr int D = 1024, NB = 16, SEQ = 4096, LC = 256, LK = SEQ + LC, TX = NB * SEQ, TC = NB * LC, TT = TX + TC;
constexpr int NH = 8, DFF = 2816, NMODC = 9 * D, NKT = LK / 64;
constexpr int NPHASE = 15;
constexpr float EPS = 1e-6f;
constexpr float QSCALE = 0.125f * 1.4426950408889634f;

constexpr size_t al256(size_t x) { return (x + 255) & ~(size_t)255; }
constexpr size_t WS_W13_1 = 0;
constexpr size_t WS_W2_1 = WS_W13_1 + (size_t)2 * DFF * D * 2;
constexpr size_t WS_WIN_M = WS_W2_1 + (size_t)D * DFF * 2;
constexpr size_t WS_WIN_V = WS_WIN_M + (size_t)4608 * D * 2;
constexpr size_t WS_WGLU = WS_WIN_V + (size_t)D * D * 2;
constexpr size_t WS_WPA = WS_WGLU + (size_t)512 * 512 * 2;
constexpr size_t WS_WPS = WS_WPA + (size_t)D * D * 2;
constexpr size_t WS_WOUT = WS_WPS + (size_t)D * 512 * 2;
constexpr size_t WS_W13_2 = WS_WOUT + (size_t)D * D * 2;
constexpr size_t WS_W2_2 = WS_W13_2 + (size_t)2 * DFF * D * 2;
constexpr size_t WS_MOD = WS_W2_2 + (size_t)D * DFF * 2;
constexpr size_t WS_ROPE = al256(WS_MOD + (size_t)17 * NMODC * 4);
constexpr size_t WS_S5A = WS_ROPE + (size_t)2 * SEQ * 32 * 4;
constexpr size_t WS_SBB = WS_S5A + (size_t)2 * 2 * 32 * 64 * 4;
constexpr size_t WS_SCM = WS_SBB + (size_t)2 * 32 * 128 * 16 * 2;
constexpr size_t WS_LAM = WS_SCM + (size_t)2 * 32 * 16 * 128 * 2;
constexpr size_t WS_BAR = WS_LAM + 256;
constexpr size_t WS_X1 = al256(WS_BAR + 256);
constexpr size_t WS_HBUF = WS_X1 + (size_t)TT * D * 4;
constexpr size_t WS_ACT = WS_HBUF + (size_t)TT * D * 2;
constexpr size_t WS_VT = WS_ACT + (size_t)TT * DFF * 2;
constexpr size_t WS_END = WS_VT + (size_t)NB * NH * LK * 128 * 2;
constexpr size_t WS_Y = WS_HBUF;
constexpr size_t WS_QB = WS_ACT;
constexpr size_t WS_KB = WS_QB + (size_t)TX * D * 2;
constexpr size_t WS_UG = WS_KB + (size_t)NB * NH * LK * 128 * 2;
constexpr size_t WS_YG = WS_KB;
constexpr size_t WS_SX = WS_KB + (size_t)TX * 512 * 2;
constexpr size_t WS_MBUF = WS_VT;
static_assert(WS_UG + (size_t)NB * 32 * LK * 16 * 2 <= WS_VT, "overlay overflow");
static_assert(WS_SX + (size_t)TX * 512 * 2 <= WS_UG, "overlay overflow");

constexpr int LDS_BYTES = 157696;

struct Args { const float* in[34]; float* out; unsigned char* ws; int ph_lo, ph_hi; };

typedef __bf16 bf16x2_t __attribute__((ext_vector_type(2)));
typedef float f32x2_t __attribute__((ext_vector_type(2)));
__device__ __forceinline__ unsigned pk2(float lo, float hi) { f32x2_t v = {lo, hi}; bf16x2_t r = __builtin_convertvector(v, bf16x2_t); return __builtin_bit_cast(unsigned, r); }
__device__ __forceinline__ float bf2f(unsigned short b) { return __uint_as_float(((unsigned)b) << 16); }
__device__ __forceinline__ float bflo(unsigned w) { return __uint_as_float(w << 16); }
__device__ __forceinline__ float bfhi(unsigned w) { return __uint_as_float(w & 0xffff0000u); }
__device__ __forceinline__ float fexp2(float x) { return __builtin_amdgcn_exp2f(x); }
__device__ __forceinline__ float frcp(float x) { return __builtin_amdgcn_rcpf(x); }
__device__ __forceinline__ float sigmoidf_(float x) { return frcp(1.f + fexp2(-1.4426950408889634f * x)); }
__device__ __forceinline__ float siluf_(float x) { return x * sigmoidf_(x); }
__device__ __forceinline__ float gelu_tanh(float x) { const float u = 0.7978845608028654f * (x + 0.044715f * x * x * x); return x * sigmoidf_(2.f * u); }
__device__ __forceinline__ float wave_sum(float v) {
#pragma unroll
    for (int o = 1; o < 64; o <<= 1) v += __shfl_xor(v, o);
    return v;
}
__device__ __forceinline__ int opq(int x) { asm volatile("" : "+v"(x)); return x; }
__device__ __forceinline__ int lane_id() { return (int)__builtin_amdgcn_mbcnt_hi(~0u, __builtin_amdgcn_mbcnt_lo(~0u, 0u)); }
#define LDS_WAIT() asm volatile("s_waitcnt lgkmcnt(0)" ::: "memory")
#define CFENCE() asm volatile("" ::: "memory")

namespace pg8 {
constexpr int BM = 256, BK = 64, HALF = 128, HTB = HALF * BK * 2, STAGE_BYTES = 8 * HTB, NXCD = 8, WGM = 8;
__host__ __device__ __forceinline__ int lds_byte(int r, int c) { const int st = (r >> 4) * 2 + (c >> 5), rr = r & 15, cc = c & 31, ob = rr * 64 + cc * 2; return st * 1024 + (ob ^ (((ob >> 9) & 1) << 5)); }
__host__ __device__ __forceinline__ void stage_rc(int b, int& R, int& C) { const int st = b / 1024, sb = b % 1024, swz = sb ^ (((sb >> 9) & 1) << 5); R = (st >> 1) * 16 + swz / 64; C = (st & 1) * 32 + (swz % 64) / 2; }
__host__ __device__ __forceinline__ int perm32(int rho) { const int n = rho >> 4, i = rho & 15; return 8 * (i >> 2) + 4 * n + (i & 3); }
struct Unit { int pm, pn; };
struct Gemm { const bf16_t* A; const bf16_t* Bt; int K; };

struct SegOrder {
    int nM1, nN1, n1, pm2, nM2, pn2, nN2, n2, G, c;
    __device__ __forceinline__ void init(int nM1_, int nN1_, int pm2_, int nM2_, int pn2_, int nN2_, int G_, int c_) {
        nM1 = nM1_; nN1 = nN1_; n1 = nM1 * nN1; pm2 = pm2_; nM2 = nM2_; pn2 = pn2_; nN2 = nN2_; n2 = nM2 * nN2; G = G_; c = c_; }
    __device__ __forceinline__ bool next(int i, Unit& u) const {
        long L = (long)i * G + c;
        if (L < n1) {
            int wgid = (int)L; { const int q = n1 / NXCD, r = n1 % NXCD, xcd = wgid % NXCD, off = wgid / NXCD; wgid = (xcd < r ? xcd * (q + 1) : r * (q + 1) + (xcd - r) * q) + off; }
            const int nig = WGM * nN1, gid = wgid / nig, fm = gid * WGM, gsz = (nM1 - fm) < WGM ? (nM1 - fm) : WGM;
            u.pm = fm + ((wgid % nig) % gsz); u.pn = (wgid % nig) / gsz; return true;
        }
        L -= n1; if (L >= n2) return false;
        u.pm = pm2 + (int)(L / nN2); u.pn = pn2 + (int)(L % nN2); return true;
    }
};

template <class Epi, bool SWAP>
__device__ __forceinline__ void gemm_phase(LAS unsigned char* lds, const Gemm g, const SegOrder& S, const Epi& E, int wid) {
    const int lane = opq(lane_id()), tid = wid * 64 + lane, wr = wid >> 2, wc = wid & 3, fr = lane & 15, fq = lane >> 4;
    const int K = g.K, nt = K / BK;
    unsigned voffA[2], voffB[2];
#pragma unroll
    for (int i = 0; i < 2; ++i) { int R, C; stage_rc(tid * 16 + i * 8192, R, C); const int Rb = Epi::PERM ? ((R & ~31) + perm32(R & 31)) : R;
        voffA[i] = (unsigned)(R * K + C) * 2u; voffB[i] = (unsigned)(Rb * K + C) * 2u; }
    const size_t kstep = (size_t)(BK * 2);
    const size_t hstep = (size_t)HALF * K * 2;
    const size_t tstep = 2 * hstep;
    const unsigned ldsw = (unsigned)wid * 1024u;
    const int aoff = lds_byte(wr * 64 + fr, fq * 8), boff = lds_byte(wc * 32 + fr, fq * 8);
#define PG8_SA(b, h) (((b) * 2 + (h)) * HTB)
#define PG8_SB(b, h) ((4 + (b) * 2 + (h)) * HTB)
#define PG8_STAGE(bufoff, gbase, voff) do { _Pragma("unroll") for (int _i = 0; _i < 2; ++_i) \
        __builtin_amdgcn_global_load_lds((const unsigned*)((const char*)(gbase) + (voff)[_i]), (LAS unsigned*)(lds + (bufoff) + ldsw + _i * 8192), 16, 0, 0); } while (0)
#define PG8_LDA(dst, b, h) do { _Pragma("unroll") for (int m = 0; m < 4; ++m) _Pragma("unroll") for (int k = 0; k < 2; ++k) dst[m][k] = *(const LAS bf16x8*)(lds + PG8_SA(b, h) + aoff + m * 2048 + k * 1024); } while (0)
#define PG8_LDB(dst, b, h) do { _Pragma("unroll") for (int n = 0; n < 2; ++n) _Pragma("unroll") for (int k = 0; k < 2; ++k) dst[n][k] = *(const LAS bf16x8*)(lds + PG8_SB(b, h) + boff + n * 2048 + k * 1024); } while (0)
#define PG8_MMA(ai, bj, At, Bt) do { __builtin_amdgcn_s_setprio(1); _Pragma("unroll") for (int m = 0; m < 4; ++m) _Pragma("unroll") for (int n = 0; n < 2; ++n) _Pragma("unroll") for (int k = 0; k < 2; ++k) \
        acc[ai][bj][m][n] = SWAP ? __builtin_amdgcn_mfma_f32_16x16x32_bf16(At[m][k], Bt[n][k], acc[ai][bj][m][n], 0, 0, 0) \
                                 : __builtin_amdgcn_mfma_f32_16x16x32_bf16(Bt[n][k], At[m][k], acc[ai][bj][m][n], 0, 0, 0); __builtin_amdgcn_s_setprio(0); } while (0)
#define PG8_WAIT_V(n) asm volatile("s_waitcnt vmcnt(" #n ")" ::: "memory")
#define PG8_WAIT_L(n) asm volatile("s_waitcnt lgkmcnt(" #n ")" ::: "memory")
#define PG8_BAR __builtin_amdgcn_s_barrier()
#define PG8_SCHED __builtin_amdgcn_sched_barrier(0)
    Unit cur, nxt; int ui = 0;
    if (!S.next(0, cur)) return;
    f32x4 acc[2][2][4][2];
#pragma unroll
    for (int a = 0; a < 2; ++a)
#pragma unroll
        for (int b = 0; b < 2; ++b)
#pragma unroll
            for (int m = 0; m < 4; ++m)
#pragma unroll
                for (int n = 0; n < 2; ++n) acc[a][b][m][n] = (f32x4){0.f, 0.f, 0.f, 0.f};
    bf16x8 At[4][2], B0[2][2], B1[2][2];
    const char* cA = (const char*)g.A + (size_t)cur.pm * tstep; const char* cB = (const char*)g.Bt + (size_t)cur.pn * tstep;
    PG8_STAGE(PG8_SB(0, 0), cB, voffB); PG8_STAGE(PG8_SA(0, 0), cA, voffA); PG8_STAGE(PG8_SB(0, 1), cB + hstep, voffB); PG8_STAGE(PG8_SA(0, 1), cA + hstep, voffA);
    if (wr == 1) PG8_BAR;
    PG8_WAIT_V(4); PG8_BAR;
    PG8_STAGE(PG8_SB(1, 0), cB + kstep, voffB); PG8_STAGE(PG8_SA(1, 0), cA + kstep, voffA); PG8_STAGE(PG8_SB(1, 1), cB + hstep + kstep, voffB);
    PG8_WAIT_V(6); PG8_BAR;
    for (;;) {
        const bool has_next = S.next(ui + 1, nxt);
        const char* nA = has_next ? (const char*)g.A + (size_t)nxt.pm * tstep : cA; const char* nB = has_next ? (const char*)g.Bt + (size_t)nxt.pn * tstep : cB;
        for (int t = 0; t < nt; t += 2) {
            const bool last = (t == nt - 2);
            const char* a1 = cA + (size_t)(t + 1) * kstep;
            const char* a2 = last ? nA : cA + (size_t)(t + 2) * kstep; const char* b2 = last ? nB : cB + (size_t)(t + 2) * kstep;
            const char* a3 = a2 + kstep; const char* b3 = b2 + kstep;
            PG8_LDB(B0, 0, 0); PG8_SCHED; PG8_LDA(At, 0, 0); PG8_STAGE(PG8_SA(1, 1), a1 + hstep, voffA);
            PG8_WAIT_L(8); PG8_BAR; PG8_WAIT_L(0); PG8_MMA(0, 0, At, B0); PG8_BAR; PG8_SCHED;
            PG8_LDB(B1, 0, 1); PG8_STAGE(PG8_SB(0, 0), b2, voffB);
            PG8_BAR; PG8_WAIT_L(0); PG8_MMA(0, 1, At, B1); PG8_BAR;
            PG8_LDA(At, 0, 1); PG8_STAGE(PG8_SA(0, 0), a2, voffA);
            PG8_BAR; PG8_WAIT_L(0); PG8_MMA(1, 0, At, B0); PG8_BAR; PG8_SCHED;
            PG8_STAGE(PG8_SB(0, 1), b2 + hstep, voffB);
            PG8_WAIT_V(6); PG8_BAR; PG8_MMA(1, 1, At, B1); PG8_BAR;
            PG8_LDB(B0, 1, 0); PG8_SCHED; PG8_LDA(At, 1, 0); PG8_STAGE(PG8_SA(0, 1), a2 + hstep, voffA);
            PG8_WAIT_L(8); PG8_BAR; PG8_WAIT_L(0); PG8_MMA(0, 0, At, B0); PG8_BAR; PG8_SCHED;
            PG8_LDB(B1, 1, 1); PG8_STAGE(PG8_SB(1, 0), b3, voffB);
            PG8_BAR; PG8_WAIT_L(0); PG8_MMA(0, 1, At, B1); PG8_BAR;
            PG8_LDA(At, 1, 1); PG8_STAGE(PG8_SA(1, 0), a3, voffA);
            PG8_BAR; PG8_WAIT_L(0); PG8_MMA(1, 0, At, B0); PG8_BAR; PG8_SCHED;
            PG8_STAGE(PG8_SB(1, 1), b3 + hstep, voffB);
            PG8_WAIT_V(6); PG8_BAR; PG8_MMA(1, 1, At, B1); PG8_BAR;
        }
        E(acc, cur, wr, wc, fr, fq);
        if (!has_next) break;
#pragma unroll
        for (int a = 0; a < 2; ++a)
#pragma unroll
            for (int b = 0; b < 2; ++b)
#pragma unroll
                for (int m = 0; m < 4; ++m)
#pragma unroll
                    for (int n = 0; n < 2; ++n) acc[a][b][m][n] = (f32x4){0.f, 0.f, 0.f, 0.f};
        cur = nxt; cA = nA; cB = nB; ++ui;
    }
    PG8_WAIT_V(0);
    if (wr == 0) PG8_BAR;
    PG8_BAR;
#undef PG8_SA
#undef PG8_SB
#undef PG8_STAGE
#undef PG8_LDA
#undef PG8_LDB
#undef PG8_MMA
#undef PG8_WAIT_V
#undef PG8_WAIT_L
#undef PG8_BAR
#undef PG8_SCHED
}
}
using pg8::Unit;


struct EpiSwiglu {
    static constexpr bool PERM = true;
    bf16_t* O;
    __device__ __forceinline__ void operator()(const f32x4 (&acc)[2][2][4][2], const Unit& u, int wr, int wc, int fr, int fq) const {
        const int row0 = u.pm * 256 + wr * 64 + fr, col0 = u.pn * 128 + wc * 32 + 8 * fq;
#pragma unroll
        for (int ai = 0; ai < 2; ++ai)
#pragma unroll
            for (int m = 0; m < 4; ++m) {
                const f32x4 a0 = acc[ai][0][m][0], a1 = acc[ai][0][m][1], b0 = acc[ai][1][m][0], b1 = acc[ai][1][m][1];
                u32x4 w;
                w.x = pk2(siluf_(a0[0]) * b0[0], siluf_(a0[1]) * b0[1]); w.y = pk2(siluf_(a0[2]) * b0[2], siluf_(a0[3]) * b0[3]);
                w.z = pk2(siluf_(a1[0]) * b1[0], siluf_(a1[1]) * b1[1]); w.w = pk2(siluf_(a1[2]) * b1[2], siluf_(a1[3]) * b1[3]);
                *(u32x4*)(O + (size_t)(row0 + ai * 128 + m * 16) * DFF + col0) = w;
            }
    }
};

struct EpiResid {
    static constexpr bool PERM = false;
    const float* srcX; const float* srcC; float* dst; const float* gate; float coef;
    __device__ __forceinline__ void operator()(const f32x4 (&acc)[2][2][4][2], const Unit& u, int wr, int wc, int fr, int fq) const {
        const int mb = u.pm < 256 ? (u.pm >> 4) : 16;
        const float* sp = u.pm < 256 ? srcX + (size_t)u.pm * 256 * D : srcC + (size_t)(u.pm - 256) * 256 * D;
        float* dp = dst + (size_t)u.pm * 256 * D;
        const int rl = wr * 64 + fr, col0 = u.pn * 256 + wc * 32 + 4 * fq;
        f32x4 gv[2][2];
#pragma unroll
        for (int bj = 0; bj < 2; ++bj)
#pragma unroll
            for (int n = 0; n < 2; ++n) gv[bj][n] = *(const f32x4*)(gate + (size_t)mb * NMODC + col0 + bj * 128 + n * 16) * coef;
#pragma unroll
        for (int ai = 0; ai < 2; ++ai)
#pragma unroll
            for (int m = 0; m < 4; ++m) {
                const size_t ro = (size_t)(rl + ai * 128 + m * 16) * D + col0;
#pragma unroll
                for (int bj = 0; bj < 2; ++bj)
#pragma unroll
                    for (int n = 0; n < 2; ++n) { const f32x4 s = *(const f32x4*)(sp + ro + bj * 128 + n * 16); *(f32x4*)(dp + ro + bj * 128 + n * 16) = s + gv[bj][n] * acc[ai][bj][m][n]; }
            }
    }
};

struct EpiInMain {
    static constexpr bool PERM = true;
    bf16_t* QB; bf16_t* KB; bf16_t* UG; bf16_t* GA; bf16_t* GS; const float* qn; const float* kn; const float* ropec; const float* ropes;
    __device__ __forceinline__ void operator()(const f32x4 (&acc)[2][2][4][2], const Unit& u, int wr, int wc, int fr, int fq) const {
        const int pn = u.pn; const bool isx = u.pm < 256;
        const int rl = wr * 64 + fr;
        if (pn < 8) {
            const bool isq = pn < 4;
            const float* gn = isq ? qn : kn;
            f32x4 g[2][2];
#pragma unroll
            for (int bj = 0; bj < 2; ++bj)
#pragma unroll
                for (int n = 0; n < 2; ++n) g[bj][n] = *(const f32x4*)(gn + 32 * bj + 8 * fq + 4 * n);
            const int hcg = 4 * (pn & 3) + wc, head = hcg >> 1, comp = hcg & 1;
#pragma unroll
            for (int ai = 0; ai < 2; ++ai)
#pragma unroll
                for (int m = 0; m < 4; ++m) {
                    const int r = u.pm * 256 + rl + ai * 128 + m * 16;
                    f32x4 v[2][2]; float ss = 0.f;
#pragma unroll
                    for (int bj = 0; bj < 2; ++bj)
#pragma unroll
                        for (int n = 0; n < 2; ++n) { v[bj][n] = acc[ai][bj][m][n]; ss += (v[bj][n][0] * v[bj][n][0] + v[bj][n][1] * v[bj][n][1]) + (v[bj][n][2] * v[bj][n][2] + v[bj][n][3] * v[bj][n][3]); }
                    ss += __shfl_xor(ss, 16); ss += __shfl_xor(ss, 32);
                    const float rstd = rsqrtf(ss * (1.f / 64.f) + EPS);
#pragma unroll
                    for (int bj = 0; bj < 2; ++bj)
#pragma unroll
                        for (int n = 0; n < 2; ++n) v[bj][n] = v[bj][n] * rstd * g[bj][n];
                    if (isx) {
                        const int t = r & (SEQ - 1);
#pragma unroll
                        for (int n = 0; n < 2; ++n) {
                            const f32x4 cs = *(const f32x4*)(ropec + t * 32 + 8 * fq + 4 * n), sn = *(const f32x4*)(ropes + t * 32 + 8 * fq + 4 * n);
                            const f32x4 t1 = v[0][n], t2 = v[1][n];
                            v[0][n] = t1 * cs - t2 * sn; v[1][n] = t2 * cs + t1 * sn;
                        }
                    }
                    bf16_t* dstp;
                    if (isq) {
#pragma unroll
                        for (int bj = 0; bj < 2; ++bj)
#pragma unroll
                            for (int n = 0; n < 2; ++n) v[bj][n] = v[bj][n] * QSCALE;
                        dstp = QB + (size_t)r * D + hcg * 64 + 8 * fq;
                    } else {
                        int b, pos; if (isx) { b = r >> 12; pos = LC + (r & (SEQ - 1)); } else { const int rc = r - TX; b = rc >> 8; pos = rc & (LC - 1); }
                        dstp = KB + (((size_t)(b * NH + head) * LK + pos) * 2 + comp) * 64 + 8 * fq;
                    }
#pragma unroll
                    for (int bj = 0; bj < 2; ++bj) {
                        u32x4 w; w.x = pk2(v[bj][0][0], v[bj][0][1]); w.y = pk2(v[bj][0][2], v[bj][0][3]); w.z = pk2(v[bj][1][0], v[bj][1][1]); w.w = pk2(v[bj][1][2], v[bj][1][3]);
                        *(u32x4*)(dstp + 32 * bj) = w;
                    }
                }
        } else if (pn < 10) {
#pragma unroll
            for (int ai = 0; ai < 2; ++ai)
#pragma unroll
                for (int m = 0; m < 4; ++m) {
                    const int r = u.pm * 256 + rl + ai * 128 + m * 16;
                    int b, pos; if (isx) { b = r >> 12; pos = LC + (r & (SEQ - 1)); } else { const int rc = r - TX; b = rc >> 8; pos = rc & (LC - 1); }
#pragma unroll
                    for (int bj = 0; bj < 2; ++bj) {
                        const int ch0 = 256 * (pn - 8) + 128 * bj + 32 * wc + 8 * fq, gidx = ch0 >> 4, c0 = ch0 & 15;
                        const f32x4 v0 = acc[ai][bj][m][0], v1 = acc[ai][bj][m][1];
                        u32x4 w; w.x = pk2(v0[0], v0[1]); w.y = pk2(v0[2], v0[3]); w.z = pk2(v1[0], v1[1]); w.w = pk2(v1[2], v1[3]);
                        *(u32x4*)(UG + ((size_t)(b * 32 + gidx) * LK + pos) * 16 + c0) = w;
                    }
                }
        } else {
            bf16_t* Gd = pn < 14 ? GA : GS; const int pq = pn < 14 ? pn - 10 : pn - 14;
#pragma unroll
            for (int ai = 0; ai < 2; ++ai)
#pragma unroll
                for (int m = 0; m < 4; ++m) {
                    const int r = u.pm * 256 + rl + ai * 128 + m * 16;
#pragma unroll
                    for (int bj = 0; bj < 2; ++bj) {
                        const f32x4 v0 = acc[ai][bj][m][0], v1 = acc[ai][bj][m][1];
                        u32x4 w; w.x = pk2(sigmoidf_(v0[0]), sigmoidf_(v0[1])); w.y = pk2(sigmoidf_(v0[2]), sigmoidf_(v0[3])); w.z = pk2(sigmoidf_(v1[0]), sigmoidf_(v1[1])); w.w = pk2(sigmoidf_(v1[2]), sigmoidf_(v1[3]));
                        *(u32x4*)(Gd + (size_t)r * D + 256 * pq + 128 * bj + 32 * wc + 8 * fq) = w;
                    }
                }
        }
    }
};

struct EpiInV {
    static constexpr bool PERM = false;
    bf16_t* VT;
    __device__ __forceinline__ void operator()(const f32x4 (&acc)[2][2][4][2], const Unit& u, int wr, int wc, int fr, int fq) const {
        const bool isx = u.pm < 256;
#pragma unroll
        for (int ai = 0; ai < 2; ++ai)
#pragma unroll
            for (int m = 0; m < 4; ++m) {
                const int r = u.pm * 256 + ai * 128 + wr * 64 + m * 16 + 4 * fq;
                int b, pos; if (isx) { b = r >> 12; pos = LC + (r & (SEQ - 1)); } else { const int rc = r - TX; b = rc >> 8; pos = rc & (LC - 1); }
                const int tile = pos >> 6, kp = pos & 63, k16 = kp & 15, sp = (kp & 48) + 8 * ((k16 >> 2) & 1) + 4 * (k16 >> 3);
#pragma unroll
                for (int bj = 0; bj < 2; ++bj)
#pragma unroll
                    for (int n = 0; n < 2; ++n) {
                        const int col = u.pn * 256 + bj * 128 + wc * 32 + n * 16 + fr, h = col >> 7, dv = col & 127;
                        const f32x4 v = acc[ai][bj][m][n];
                        u32x2 w; w.x = pk2(v[0], v[1]); w.y = pk2(v[2], v[3]);
                        *(u32x2*)(VT + (((size_t)(b * NH + h) * NKT + tile) * 128 + dv) * 64 + sp) = w;
                    }
            }
    }
};

struct EpiGlu {
    static constexpr bool PERM = true;
    const bf16_t* YG; bf16_t* SX; const float* bglu;
    __device__ __forceinline__ void operator()(const f32x4 (&acc)[2][2][4][2], const Unit& u, int wr, int wc, int fr, int fq) const {
        const int row0 = u.pm * 256 + wr * 64 + fr, col0 = u.pn * 256 + wc * 32 + 8 * fq;
#pragma unroll
        for (int bj = 0; bj < 2; ++bj) {
            const f32x4 bv0 = *(const f32x4*)(bglu + col0 + bj * 128), bv1 = *(const f32x4*)(bglu + col0 + bj * 128 + 4);
#pragma unroll
            for (int ai = 0; ai < 2; ++ai)
#pragma unroll
                for (int m = 0; m < 4; ++m) {
                    const size_t o = (size_t)(row0 + ai * 128 + m * 16) * 512 + col0 + bj * 128;
                    const u32x4 y = *(const u32x4*)(YG + o);
                    const f32x4 v0 = acc[ai][bj][m][0] + bv0, v1 = acc[ai][bj][m][1] + bv1;
                    u32x4 w;
                    w.x = pk2(bflo(y.x) * sigmoidf_(v0[0]), bfhi(y.x) * sigmoidf_(v0[1])); w.y = pk2(bflo(y.y) * sigmoidf_(v0[2]), bfhi(y.y) * sigmoidf_(v0[3]));
                    w.z = pk2(bflo(y.z) * sigmoidf_(v1[0]), bfhi(y.z) * sigmoidf_(v1[1])); w.w = pk2(bflo(y.w) * sigmoidf_(v1[2]), bfhi(y.w) * sigmoidf_(v1[3]));
                    *(u32x4*)(SX + o) = w;
                }
        }
    }
};

template <bool ACCUM> struct EpiMerge {
    static constexpr bool PERM = true;
    const bf16_t* Gt; bf16_t* Mb;
    __device__ __forceinline__ void operator()(const f32x4 (&acc)[2][2][4][2], const Unit& u, int wr, int wc, int fr, int fq) const {
        const int row0 = u.pm * 256 + wr * 64 + fr, col0 = u.pn * 256 + wc * 32 + 8 * fq;
#pragma unroll
        for (int ai = 0; ai < 2; ++ai)
#pragma unroll
            for (int m = 0; m < 4; ++m)
#pragma unroll
                for (int bj = 0; bj < 2; ++bj) {
                    const size_t o = (size_t)(row0 + ai * 128 + m * 16) * D + col0 + bj * 128;
                    const u32x4 gt = *(const u32x4*)(Gt + o);
                    const f32x4 v0 = acc[ai][bj][m][0], v1 = acc[ai][bj][m][1];
                    float r0 = bflo(gt.x) * v0[0], r1 = bfhi(gt.x) * v0[1], r2 = bflo(gt.y) * v0[2], r3 = bfhi(gt.y) * v0[3];
                    float r4 = bflo(gt.z) * v1[0], r5 = bfhi(gt.z) * v1[1], r6 = bflo(gt.w) * v1[2], r7 = bfhi(gt.w) * v1[3];
                    if (ACCUM) { const u32x4 p = *(const u32x4*)(Mb + o);
                        r0 += bflo(p.x); r1 += bfhi(p.x); r2 += bflo(p.y); r3 += bfhi(p.y); r4 += bflo(p.z); r5 += bfhi(p.z); r6 += bflo(p.w); r7 += bfhi(p.w); }
                    u32x4 w; w.x = pk2(r0, r1); w.y = pk2(r2, r3); w.z = pk2(r4, r5); w.w = pk2(r6, r7);
                    *(u32x4*)(Mb + o) = w;
                }
    }
};

__device__ __forceinline__ void tr_item(const float* W, int K, int N, int k0, int scol0, bf16_t* WT, int drow0, LAS float* scr, int lane) {
#pragma unroll 8
    for (int i = 0; i < 32; ++i) { const int kk = 2 * i + (lane >> 5); scr[kk * 33 + (lane & 31)] = W[(size_t)(k0 + kk) * N + scol0 + (lane & 31)]; }
    LDS_WAIT();
    const int c = lane & 7;
#pragma unroll
    for (int j = 0; j < 4; ++j) { const int n = (lane >> 3) + 8 * j; const LAS float* s = scr + (8 * c) * 33 + n;
        u32x4 o; o.x = pk2(s[0 * 33], s[1 * 33]); o.y = pk2(s[2 * 33], s[3 * 33]); o.z = pk2(s[4 * 33], s[5 * 33]); o.w = pk2(s[6 * 33], s[7 * 33]);
        *(u32x4*)(WT + (size_t)(drow0 + n) * K + k0 + 8 * c) = o; }
    LDS_WAIT();
}
__device__ __forceinline__ int src_w13(int n0) { const int pn = n0 >> 8, s = n0 & 255; return (s >> 7) * DFF + 128 * pn + (s & 127); }
__device__ __forceinline__ int src_winm(int n0) {
    if (n0 < 2048) { const int base = n0 < 1024 ? 0 : 1024, nn = n0 - base, pn = nn >> 8, s = nn & 255, bj = s >> 7, wc = (s & 127) >> 5, hcg = 4 * pn + wc; return base + hcg * 64 + 32 * bj; }
    if (n0 < 2560) return 3072 + (n0 - 2048);
    return 3584 + (n0 - 2560);
}

__global__ void __launch_bounds__(512, 2) mega(Args a) {
    extern __shared__ __attribute__((aligned(16))) unsigned char smem[];
    LAS unsigned char* lds = (LAS unsigned char*)smem;
    const int wave = __builtin_amdgcn_readfirstlane(threadIdx.x >> 6);
    const int G = gridDim.x, cb = blockIdx.x;
    const int gw = cb * 8 + wave, NW = G * 8;
    unsigned char* ws = a.ws;
    bf16_t* W13_1 = (bf16_t*)(ws + WS_W13_1); bf16_t* W2_1 = (bf16_t*)(ws + WS_W2_1); bf16_t* WINM = (bf16_t*)(ws + WS_WIN_M); bf16_t* WINV = (bf16_t*)(ws + WS_WIN_V);
    bf16_t* WGLU = (bf16_t*)(ws + WS_WGLU); bf16_t* WPA = (bf16_t*)(ws + WS_WPA); bf16_t* WPS = (bf16_t*)(ws + WS_WPS); bf16_t* WOUT = (bf16_t*)(ws + WS_WOUT);
    bf16_t* W13_2 = (bf16_t*)(ws + WS_W13_2); bf16_t* W2_2 = (bf16_t*)(ws + WS_W2_2);
    float* MOD = (float*)(ws + WS_MOD); float* ROPEC = (float*)(ws + WS_ROPE); float* ROPES = ROPEC + SEQ * 32;
    float* S5AR = (float*)(ws + WS_S5A); float* S5AI = S5AR + 2 * 32 * 64; bf16_t* SBB = (bf16_t*)(ws + WS_SBB); bf16_t* SCM = (bf16_t*)(ws + WS_SCM); float* LAMP = (float*)(ws + WS_LAM);
    float* X1 = (float*)(ws + WS_X1); bf16_t* HBUF = (bf16_t*)(ws + WS_HBUF); bf16_t* ACT = (bf16_t*)(ws + WS_ACT); bf16_t* VT = (bf16_t*)(ws + WS_VT);
    bf16_t* YB = (bf16_t*)(ws + WS_Y); bf16_t* QB = (bf16_t*)(ws + WS_QB); bf16_t* KB = (bf16_t*)(ws + WS_KB); bf16_t* UG = (bf16_t*)(ws + WS_UG);
    bf16_t* YG = (bf16_t*)(ws + WS_YG); bf16_t* SX = (bf16_t*)(ws + WS_SX); bf16_t* MBUF = (bf16_t*)(ws + WS_MBUF);
    bf16_t* GA = (bf16_t*)a.out; bf16_t* GS = GA + (size_t)TX * D;
    const float* Xin = a.in[0]; const float* Cin = a.in[2];

#ifndef PHMASK
#define PHMASK 0x7fff
#endif
#define PH(n) if (((PHMASK >> (n)) & 1) && a.ph_lo <= (n) && (n) < a.ph_hi)
#if MK_SPLIT
#define GSYNC(n) do { } while (0)
#else
#define GSYNC(n) do { if (a.ph_lo <= (n) && (n) + 1 < a.ph_hi) { bar_t += (unsigned)G; \
        asm volatile("s_waitcnt vmcnt(0) lgkmcnt(0)" ::: "memory");       \
        __syncthreads(); \
        if (wave == 0) {                                                   \
            __builtin_amdgcn_fence(__ATOMIC_RELEASE, "agent"); asm volatile("s_waitcnt vmcnt(0)" ::: "memory"); \
            if (lane_id() == 0) { __hip_atomic_fetch_add(BARW, 1u, __ATOMIC_RELAXED, __HIP_MEMORY_SCOPE_AGENT); \
                while (__hip_atomic_load(BARW, __ATOMIC_RELAXED, __HIP_MEMORY_SCOPE_AGENT) < bar_t) __builtin_amdgcn_s_sleep(1); } \
            __builtin_amdgcn_fence(__ATOMIC_ACQUIRE, "agent"); asm volatile("s_waitcnt vmcnt(0) lgkmcnt(0)" ::: "memory"); } \
        __syncthreads(); } } while (0)
#endif
    unsigned* BARW = (unsigned*)(ws + WS_BAR); unsigned bar_t = 0;
#if !MK_SPLIT
    if (a.ph_lo == 0) cg::this_grid().sync();
#endif

    PH(0) {
        const int lane = opq(lane_id()), tid = wave * 64 + lane;
        for (int slab = cb; slab < NMODC / 64; slab += G) {
            LAS float* sl = (LAS float*)lds;
            LAS float* red = (LAS float*)(lds + 17 * 1024 * 4);
            for (int i = tid; i < 17 * 1024; i += 512) { const int mb = i >> 10, k = i & 1023; const float v = mb < 16 ? a.in[1][mb * 1024 + k] : a.in[3][k]; sl[i] = siluf_(v); }
            __syncthreads();
            float accm[17];
#pragma unroll
            for (int j = 0; j < 17; ++j) accm[j] = 0.f;
            const float* wp = a.in[4] + (size_t)(wave * 128) * NMODC + slab * 64 + lane;
#pragma unroll 4
            for (int k = 0; k < 128; ++k) { const float w = wp[(size_t)k * NMODC];
#pragma unroll
                for (int j = 0; j < 17; ++j) accm[j] += w * sl[j * 1024 + wave * 128 + k]; }
#pragma unroll
            for (int j = 0; j < 17; ++j) red[(wave * 17 + j) * 64 + lane] = accm[j];
            __syncthreads();
            for (int i = tid; i < 17 * 64; i += 512) { const int j = i >> 6, l = i & 63; float s = a.in[5][slab * 64 + l];
#pragma unroll
                for (int w = 0; w < 8; ++w) s += red[(w * 17 + j) * 64 + l];
                MOD[(size_t)j * NMODC + slab * 64 + l] = s; }
            __syncthreads();
        }
        {
            LAS float* scr = (LAS float*)(lds + wave * 16384);
            constexpr int I13 = 16 * 176, I2 = 44 * 32, IINM = 16 * 144, IINV = 16 * 32, IGLU = 8 * 16, IPA = 16 * 32, IPS = 8 * 32, IOUT = 16 * 32;
            constexpr int NIT = 2 * I13 + 2 * I2 + IINM + IINV + IGLU + IPA + IPS + IOUT;
            for (int it = gw; it < NIT; it += NW) {
                int r = it;
                if (r < I13) { const int kb = r / 176, nb = r % 176; tr_item(a.in[7], D, 2 * DFF, 64 * kb, src_w13(32 * nb), W13_1, 32 * nb, scr, lane); continue; } r -= I13;
                if (r < I13) { const int kb = r / 176, nb = r % 176; tr_item(a.in[32], D, 2 * DFF, 64 * kb, src_w13(32 * nb), W13_2, 32 * nb, scr, lane); continue; } r -= I13;
                if (r < I2) { const int kb = r / 32, nb = r % 32; tr_item(a.in[8], DFF, D, 64 * kb, 32 * nb, W2_1, 32 * nb, scr, lane); continue; } r -= I2;
                if (r < I2) { const int kb = r / 32, nb = r % 32; tr_item(a.in[33], DFF, D, 64 * kb, 32 * nb, W2_2, 32 * nb, scr, lane); continue; } r -= I2;
                if (r < IINM) { const int kb = r / 144, nb = r % 144; tr_item(a.in[10], D, 5632, 64 * kb, src_winm(32 * nb), WINM, 32 * nb, scr, lane); continue; } r -= IINM;
                if (r < IINV) { const int kb = r / 32, nb = r % 32; tr_item(a.in[10], D, 5632, 64 * kb, 2048 + 32 * nb, WINV, 32 * nb, scr, lane); continue; } r -= IINV;
                if (r < IGLU) { const int kb = r / 16, nb = r % 16; tr_item(a.in[26], 512, 512, 64 * kb, 32 * nb, WGLU, 32 * nb, scr, lane); continue; } r -= IGLU;
                if (r < IPA) { const int kb = r / 32, nb = r % 32; tr_item(a.in[28], D, D, 64 * kb, 32 * nb, WPA, 32 * nb, scr, lane); continue; } r -= IPA;
                if (r < IPS) { const int kb = r / 32, nb = r % 32; tr_item(a.in[29], 512, D, 64 * kb, 32 * nb, WPS, 32 * nb, scr, lane); continue; } r -= IPS;
                { const int kb = r / 32, nb = r % 32; tr_item(a.in[30], D, D, 64 * kb, 32 * nb, WOUT, 32 * nb, scr, lane); }
            }
        }
        for (int i = cb * 512 + tid; i < SEQ * 32; i += G * 512) {
            const int t = i >> 5, f = i & 31; const int pos = f < 16 ? (t >> 6) : (t & 63); const int fi = f & 15;
            const float inv = (float)pow(10000.0, -(double)fi / 16.0); const float ang = (float)pos * inv;
            ROPEC[i] = (float)cos((double)ang); ROPES[i] = (float)sin((double)ang);
        }
        for (int i = cb * 512 + tid; i < 2 * 32 * 64; i += G * 512) {
            const int dg = i >> 6, p = i & 63;
            const double lre = a.in[18][i], lim = a.in[19][i], dt = exp((double)a.in[20][dg]);
            const double mag = exp(lre * dt), ar = mag * cos(lim * dt), ai = mag * sin(lim * dt), den = lre * lre + lim * lim, nr = ar - 1.0;
            const double fr_ = (nr * lre + ai * lim) / den, fi_ = (ai * lre - nr * lim) / den;
            S5AR[i] = (float)ar; S5AI[i] = (float)ai;
            const float* bre = a.in[21] + (size_t)i * 16; const float* bim = a.in[22] + (size_t)i * 16;
#pragma unroll
            for (int c2 = 0; c2 < 16; c2 += 2) {
                const double r0 = fr_ * bre[c2] - fi_ * bim[c2], r1 = fr_ * bre[c2 + 1] - fi_ * bim[c2 + 1], i0 = fr_ * bim[c2] + fi_ * bre[c2], i1 = fr_ * bim[c2 + 1] + fi_ * bre[c2 + 1];
                *(unsigned*)(SBB + ((size_t)dg * 128 + 2 * p) * 16 + c2) = pk2((float)r0, (float)r1);
                *(unsigned*)(SBB + ((size_t)dg * 128 + 2 * p + 1) * 16 + c2) = pk2((float)i0, (float)i1);
            }
        }
        for (int i = cb * 512 + tid; i < 2 * 32 * 16 * 64; i += G * 512) {
            const int p2 = (i & 31) * 2, dgc = i >> 5;
            if (i < 2 * 32 * 16 * 32) {
                const float* cre = a.in[23] + (size_t)dgc * 64; const float* cim = a.in[24] + (size_t)dgc * 64;
                *(unsigned*)(SCM + (size_t)dgc * 128 + 2 * p2) = pk2(cre[p2], -cim[p2]);
                *(unsigned*)(SCM + (size_t)dgc * 128 + 2 * p2 + 2) = pk2(cre[p2 + 1], -cim[p2 + 1]);
            }
        }
        if (cb == 0 && tid == 0) {
            float s1 = 0.f, s2 = 0.f;
            for (int i = 0; i < 64; ++i) { s1 += a.in[13][i] * a.in[14][i]; s2 += a.in[15][i] * a.in[16][i]; }
            LAMP[0] = expf(s1) - expf(s2) + 0.2f;
            float gq = 0.f, gk = 0.f;
            for (int i = 0; i < 64; ++i) { gq = fmaxf(gq, fabsf(a.in[11][i])); gk = fmaxf(gk, fabsf(a.in[12][i])); }
            LAMP[1] = 1.02f * 64.f * gq * gk * QSCALE;
        }
    }
    GSYNC(0);

    auto norm_phase = [&](const float* srcX, const float* srcC, int nrows, const float* gain, int sh_chunk, int sc_chunk) {
        const int nchunk = nrows / 8; const int lane = opq(lane_id());
        for (int ch = gw; ch < nchunk; ch += NW) {
            const int r0 = ch * 8; const int mb = r0 < TX ? (r0 >> 12) : 16;
            f32x4 ga[4], sh[4];
#pragma unroll
            for (int j = 0; j < 4; ++j) { const int c = 4 * lane + 256 * j;
                const f32x4 g4 = *(const f32x4*)(gain + c), sc4 = *(const f32x4*)(MOD + (size_t)mb * NMODC + sc_chunk * D + c);
                ga[j] = g4 * (sc4 + 1.0f); sh[j] = *(const f32x4*)(MOD + (size_t)mb * NMODC + sh_chunk * D + c); }
            for (int rr = 0; rr < 8; ++rr) {
                const int r = r0 + rr;
                const float* xr = r < TX ? srcX + (size_t)r * D : srcC + (size_t)(r - TX) * D;
                f32x4 v[4]; float s = 0.f;
#pragma unroll
                for (int j = 0; j < 4; ++j) { v[j] = *(const f32x4*)(xr + 4 * lane + 256 * j); s += (v[j][0] * v[j][0] + v[j][1] * v[j][1]) + (v[j][2] * v[j][2] + v[j][3] * v[j][3]); }
                const float rstd = rsqrtf(wave_sum(s) * (1.f / D) + EPS);
#pragma unroll
                for (int j = 0; j < 4; ++j) { const f32x4 y = v[j] * rstd * ga[j] + sh[j]; u32x2 w; w.x = pk2(y[0], y[1]); w.y = pk2(y[2], y[3]);
                    *(u32x2*)(HBUF + (size_t)r * D + 4 * lane + 256 * j) = w; }
            }
        }
    };

    PH(1) { norm_phase(Xin, Cin, TT, a.in[6], 0, 1); }
    GSYNC(1);
#ifndef REPG
#define REPG 1
#endif
#pragma unroll 1
    for (int rg = 0; rg < REPG; ++rg)
    PH(2) { pg8::SegOrder S; S.init(272, 22, 0, 0, 0, 1, G, cb); pg8::Gemm g{HBUF, W13_1, D}; EpiSwiglu E{ACT}; pg8::gemm_phase<EpiSwiglu, false>(lds, g, S, E, wave); }
    GSYNC(2);
#pragma unroll 1
    for (int rg = 0; rg < REPG; ++rg)
    PH(3) { pg8::SegOrder S; S.init(272, 4, 0, 0, 0, 1, G, cb); pg8::Gemm g{ACT, W2_1, DFF}; EpiResid E{Xin, Cin, X1, MOD + 2 * D, 0.5f}; pg8::gemm_phase<EpiResid, false>(lds, g, S, E, wave); }
    GSYNC(3);
#ifndef REP56
#define REP56 1
#endif
#pragma unroll 1
    for (int rep56 = 0; rep56 < REP56; ++rep56) {
    PH(4) { norm_phase(X1, X1 + (size_t)TX * D, TT, a.in[9], 3, 4); }
    GSYNC(4);
#ifndef REP5
#define REP5 1
#endif
#pragma unroll 1
    for (int r5 = 0; r5 < REP5; ++r5)
    PH(5) {
        { pg8::SegOrder S; S.init(256, 18, 256, 16, 4, 6, G, cb); pg8::Gemm g{HBUF, WINM, D}; EpiInMain E{QB, KB, UG, GA, GS, a.in[11], a.in[12], ROPEC, ROPES}; pg8::gemm_phase<EpiInMain, false>(lds, g, S, E, wave); }
        { pg8::SegOrder S; S.init(272, 4, 0, 0, 0, 1, G, cb); pg8::Gemm g{HBUF, WINV, D}; EpiInV E{VT}; pg8::gemm_phase<EpiInV, true>(lds, g, S, E, wave); }
    }
    GSYNC(5);

    PH(6) {
        const int lane = opq(lane_id()), tid = wave * 64 + lane;
        const int hh = lane >> 5, l31 = lane & 31;
#ifndef REPS
#define REPS 1
#endif
#pragma unroll 1
        for (int rs = 0; rs < REPS; ++rs)
        for (int si = cb; si < 256; si += G) if (wave < 4) {
            const int task = si * 4 + wave, b = task >> 6, d = (task >> 5) & 1, g = task & 31, dg = d * 32 + g;
            LAS unsigned char* wl = lds + wave * 16896;
            const float ar = S5AR[dg * 64 + lane], ai = S5AI[dg * 64 + lane];
            bf16x8 bfr[4], cfr[4];
#pragma unroll
            for (int nt = 0; nt < 4; ++nt) bfr[nt] = *(const bf16x8*)(SBB + ((size_t)dg * 128 + l31 + 32 * nt) * 16 + 8 * hh);
#pragma unroll
            for (int kk = 0; kk < 4; ++kk) cfr[kk] = *(const bf16x8*)(SCM + ((size_t)dg * 16 + (lane & 15)) * 128 + 32 * kk + 8 * (lane >> 4));
            const bf16_t* ug = UG + (size_t)(b * 32 + g) * LK * 16;
            bf16_t* yo = YB + ((size_t)d * TX + (size_t)b * SEQ) * 512 + g * 16;
            float hr = 0.f, hi = 0.f;
            auto upos = [&](int ch) { const int s = 32 * ch + l31; return d == 0 ? s : (s < LC ? LC - 1 - s : LK + LC - 1 - s); };
            bf16x8 afn = *(const bf16x8*)(ug + (size_t)upos(0) * 16 + 8 * hh);
            for (int ch = 0; ch < LK / 32; ++ch) {
                const bf16x8 af = afn;
                if (ch + 1 < LK / 32) afn = *(const bf16x8*)(ug + (size_t)upos(ch + 1) * 16 + 8 * hh);
                f32x16 bu[4];
#pragma unroll
                for (int nt = 0; nt < 4; ++nt) { f32x16 z;
#pragma unroll
                    for (int q = 0; q < 16; ++q) z[q] = 0.f;
                    bu[nt] = __builtin_amdgcn_mfma_f32_32x32x16_bf16(af, bfr[nt], z, 0, 0, 0); }
#pragma unroll
                for (int nt = 0; nt < 4; ++nt)
#pragma unroll
                    for (int r = 0; r < 16; ++r) { const int t = 8 * (r >> 2) + 4 * hh + (r & 3); *(LAS float*)(wl + t * 528 + (l31 + 32 * nt) * 4) = bu[nt][r]; }
                CFENCE();
                float br[32], bi[32];
#pragma unroll
                for (int t = 0; t < 32; ++t) { const f32x2_t v = *(const LAS f32x2_t*)(wl + t * 528 + lane * 8); br[t] = v[0]; bi[t] = v[1]; }
                CFENCE();
#pragma unroll
                for (int t = 0; t < 32; ++t) {
                    const float nhr = fmaf(-ai, hi, fmaf(ar, hr, br[t])), nhi = fmaf(ai, hr, fmaf(ar, hi, bi[t]));
                    hr = nhr; hi = nhi;
                    *(LAS unsigned*)(wl + t * 528 + lane * 4) = pk2(hr, hi);
                }
                CFENCE();
                if (ch >= LC / 32) {
#pragma unroll
                    for (int mt = 0; mt < 2; ++mt) {
                        f32x4 y = (f32x4){0.f, 0.f, 0.f, 0.f};
#pragma unroll
                        for (int kk = 0; kk < 4; ++kk) { const bf16x8 hf = *(const LAS bf16x8*)(wl + (16 * mt + (lane & 15)) * 528 + (32 * kk + 8 * (lane >> 4)) * 2);
                            y = __builtin_amdgcn_mfma_f32_16x16x32_bf16(cfr[kk], hf, y, 0, 0, 0); }
                        const int s2 = 32 * ch + 16 * mt + (lane & 15);
                        const int tok = d == 0 ? s2 - LC : (LK - 1 - s2);
                        u32x2 w; w.x = pk2(y[0], y[1]); w.y = pk2(y[2], y[3]);
                        *(u32x2*)(yo + (size_t)tok * 512 + 4 * (lane >> 4)) = w;
                    }
                }
                CFENCE();
            }
        }
        __syncthreads();
        const float negC = __builtin_amdgcn_readfirstlane(__float_as_int(LAMP[1] > 64.f ? -LAMP[1] : 0.f)) == 0 ? 0.f : -LAMP[1];
#ifndef REPA
#define REPA 1
#endif
#pragma unroll 1
        for (int repa = 0; repa < REPA; ++repa)
        for (int ai_ = cb; ai_ < NB * NH * 16 * DBG_ATT; ai_ += G) {
            const int lane = opq(lane_id()), hh = lane >> 5, l31 = lane & 31;
            const int cp = ai_ & 255, jr = ai_ >> 8;
            const int bh = 16 * jr + 2 * (cp & 7) + ((cp >> 3) >> 4), qt = (cp >> 3) & 15;
            const int b = bh >> 3, h = bh & 7;
            const int comp = wave >> 2, rg = wave & 3;
            const size_t row0 = (size_t)b * SEQ + qt * 256 + rg * 64;
            LAS unsigned char* qb_ = lds + 71680 + wave * 9216;
            {
                u32x4 qr[8];
#pragma unroll
                for (int j = 0; j < 8; ++j) { const int q = 8 * j + (lane >> 3), c = lane & 7; qr[j] = *(const u32x4*)(QB + (row0 + q) * D + h * 128 + comp * 64 + c * 8); }
#pragma unroll
                for (int j = 0; j < 8; ++j) { const int q = 8 * j + (lane >> 3), c = lane & 7; *(LAS u32x4*)(qb_ + q * 144 + c * 16) = qr[j]; }
            }
            f32x16 O[2][4];
#pragma unroll
            for (int qs = 0; qs < 2; ++qs)
#pragma unroll
                for (int mt = 0; mt < 4; ++mt)
#pragma unroll
                    for (int q = 0; q < 16; ++q) O[qs][mt][q] = 0.f;
            float lsum[2] = {0.f, 0.f};
            const bf16_t* Kg = KB + (size_t)bh * LK * 128; const bf16_t* Vg = VT + (size_t)bh * NKT * 8192;
            LAS unsigned* stab = (LAS unsigned*)(lds + 145408 + wave * 1536);
#pragma unroll
            for (int i = 0; i < 3; ++i) { const int slot = 64 * (wave + 8 * i) + lane; int key = slot / 17, c = slot % 17; if (c == 16) c = 0; if (key > 63) key = 63; stab[i * 64 + lane] = (unsigned)(key * 256 + c * 16);
                int dv = slot / 9, c2 = slot % 9; if (c2 == 8) c2 = 0; if (dv > 127) dv = 127; stab[(3 + i) * 64 + lane] = (unsigned)(dv * 128 + c2 * 16); }
            constexpr int KBUF = 17408, VBUF = 18432, VOFF = 2 * KBUF;
#define ATT_STAGE(buf, tile) do { _Pragma("unroll") for (int _i = 0; _i < 3; ++_i) { const int _j = wave + 8 * _i; \
                if (_j < 17) __builtin_amdgcn_global_load_lds((const unsigned*)((const char*)Kg + (size_t)(tile) * 16384 + stab[_i * 64 + lane]), (LAS unsigned*)(lds + (buf) * KBUF + _j * 1024), 16, 0, 0); \
                if (_j < 18) __builtin_amdgcn_global_load_lds((const unsigned*)((const char*)Vg + (size_t)(tile) * 16384 + stab[(3 + _i) * 64 + lane]), (LAS unsigned*)(lds + VOFF + (buf) * VBUF + _j * 1024), 16, 0, 0); } } while (0)
#define SOFTMAX_STEP(S, L, P) do { \
            float ps = 0.f; unsigned pw[8]; \
            if (negC != 0.f) { _Pragma("unroll") for (int q = 0; q < 16; ++q) S[q] += negC; } \
            _Pragma("unroll") for (int q = 0; q < 16; q += 2) { const float e0 = fexp2(S[q]), e1 = fexp2(S[q + 1]); ps += e0 + e1; pw[q >> 1] = pk2(e0, e1); } \
            L += ps; \
            { u32x4 t0 = (u32x4){pw[0], pw[1], pw[2], pw[3]}, t1 = (u32x4){pw[4], pw[5], pw[6], pw[7]}; P[0] = __builtin_bit_cast(bf16x8, t0); P[1] = __builtin_bit_cast(bf16x8, t1); } } while (0)
#define ATT_BAR() do { asm volatile("s_waitcnt lgkmcnt(0)" ::: "memory"); __builtin_amdgcn_s_barrier(); asm volatile("" ::: "memory"); } while (0)
            ATT_STAGE(0, 0);
            asm volatile("s_waitcnt vmcnt(0)" ::: "memory");
            __syncthreads();
            for (int it = 0; it < NKT; ++it) {
                const int cur = it & 1;
                LAS unsigned char* kb_ = lds + cur * KBUF + l31 * 272 + hh * 16 + comp * 128; LAS unsigned char* vb_ = lds + VOFF + cur * VBUF + l31 * 144 + hh * 16;
                LAS unsigned char* qa_ = qb_ + l31 * 144 + hh * 16;
                f32x16 sA0, sA1, sB0, sB1;
#pragma unroll
                for (int q = 0; q < 16; ++q) { sA0[q] = 0.f; sA1[q] = 0.f; sB0[q] = 0.f; sB1[q] = 0.f; }
#pragma unroll
                for (int kk = 0; kk < 4; ++kk) {
                    const bf16x8 kf = *(const LAS bf16x8*)(kb_ + kk * 32);
                    const bf16x8 q0 = *(const LAS bf16x8*)(qa_ + kk * 32), q1 = *(const LAS bf16x8*)(qa_ + 32 * 144 + kk * 32);
                    sA0 = __builtin_amdgcn_mfma_f32_32x32x16_bf16(kf, q0, sA0, 0, 0, 0);
                    sA1 = __builtin_amdgcn_mfma_f32_32x32x16_bf16(kf, q1, sA1, 0, 0, 0);
                }
#pragma unroll
                for (int kk = 0; kk < 4; ++kk) {
                    const bf16x8 kf = *(const LAS bf16x8*)(kb_ + 32 * 272 + kk * 32);
                    const bf16x8 q0 = *(const LAS bf16x8*)(qa_ + kk * 32), q1 = *(const LAS bf16x8*)(qa_ + 32 * 144 + kk * 32);
                    sB0 = __builtin_amdgcn_mfma_f32_32x32x16_bf16(kf, q0, sB0, 0, 0, 0);
                    sB1 = __builtin_amdgcn_mfma_f32_32x32x16_bf16(kf, q1, sB1, 0, 0, 0);
                }
                bf16x8 pA[2][2], pB[2][2];
                SOFTMAX_STEP(sA0, lsum[0], pA[0]);
                SOFTMAX_STEP(sA1, lsum[1], pA[1]);
#pragma unroll
                for (int s = 0; s < 2; ++s) {
                    if (s == 1 && it + 1 < NKT) ATT_STAGE(cur ^ 1, it + 1);
#pragma unroll
                    for (int mt = 0; mt < 4; ++mt) {
                        const bf16x8 vf = *(const LAS bf16x8*)(vb_ + mt * (32 * 144) + (2 * s) * 16);
                        O[0][mt] = __builtin_amdgcn_mfma_f32_32x32x16_bf16(vf, pA[0][s], O[0][mt], 0, 0, 0);
                        O[1][mt] = __builtin_amdgcn_mfma_f32_32x32x16_bf16(vf, pA[1][s], O[1][mt], 0, 0, 0);
                    }
                }
                SOFTMAX_STEP(sB0, lsum[0], pB[0]);
                SOFTMAX_STEP(sB1, lsum[1], pB[1]);
#pragma unroll
                for (int s = 0; s < 2; ++s)
#pragma unroll
                    for (int mt = 0; mt < 4; ++mt) {
                        const bf16x8 vf = *(const LAS bf16x8*)(vb_ + mt * (32 * 144) + (4 + 2 * s) * 16);
                        O[0][mt] = __builtin_amdgcn_mfma_f32_32x32x16_bf16(vf, pB[0][s], O[0][mt], 0, 0, 0);
                        O[1][mt] = __builtin_amdgcn_mfma_f32_32x32x16_bf16(vf, pB[1][s], O[1][mt], 0, 0, 0);
                    }
                asm volatile("s_waitcnt vmcnt(0)" ::: "memory"); ATT_BAR();
            }
            const int lane2 = opq(lane_id()), hh2 = lane2 >> 5, l31b = lane2 & 31;
            lsum[0] += __shfl_xor(lsum[0], 32); lsum[1] += __shfl_xor(lsum[1], 32);
            LAS float* xb = (LAS float*)(lds + rg * 32768) + lane2;
            if (comp == 1) {
                const float lam = LAMP[0];
#pragma unroll
                for (int qs = 0; qs < 2; ++qs) { const float sc = lam * frcp(lsum[qs]);
#pragma unroll
                    for (int mt = 0; mt < 4; ++mt)
#pragma unroll
                        for (int q = 0; q < 16; ++q) xb[((qs * 4 + mt) * 16 + q) * 64] = O[qs][mt][q] * sc; }
            }
            __syncthreads();
            if (comp == 0) {
#pragma unroll
                for (int qs = 0; qs < 2; ++qs) {
                    const float i0 = frcp(lsum[qs]); float ss = 0.f;
#pragma unroll
                    for (int mt = 0; mt < 4; ++mt)
#pragma unroll
                        for (int q = 0; q < 16; ++q) { const float o = O[qs][mt][q] * i0 - xb[((qs * 4 + mt) * 16 + q) * 64]; O[qs][mt][q] = o; ss += o * o; }
                    ss += __shfl_xor(ss, 32);
                    const float rstd = rsqrtf(ss * (1.f / 128.f) + EPS) * 0.8f;
                    bf16_t* op = QB + (row0 + 32 * qs + l31b) * D + h * 128 + 4 * hh2;
#pragma unroll
                    for (int mt = 0; mt < 4; ++mt)
#pragma unroll
                        for (int q4 = 0; q4 < 4; ++q4) {
                            const f32x4 sg = *(const f32x4*)(a.in[17] + 32 * mt + 8 * q4 + 4 * hh2);
                            u32x2 w; w.x = pk2(O[qs][mt][4 * q4] * rstd * sg[0], O[qs][mt][4 * q4 + 1] * rstd * sg[1]); w.y = pk2(O[qs][mt][4 * q4 + 2] * rstd * sg[2], O[qs][mt][4 * q4 + 3] * rstd * sg[3]);
                            *(u32x2*)(op + 32 * mt + 8 * q4) = w;
                        }
                }
            }
            __syncthreads();
        }
    }
    GSYNC(6);
    }

#define BSYNC() do { asm volatile("s_waitcnt vmcnt(0) lgkmcnt(0)" ::: "memory"); __syncthreads(); \
        if (wave == 0) { __builtin_amdgcn_fence(__ATOMIC_ACQUIRE, "agent"); asm volatile("s_waitcnt vmcnt(0) lgkmcnt(0)" ::: "memory"); } __syncthreads(); } while (0)
    PH(7) {
        for (int pm = cb; pm < TX / 256; pm += G) {
            {
                const int tid = wave * 64 + opq(lane_id());
                for (int i = tid; i < 256 * 64; i += 512) {
                    const size_t tok = (size_t)pm * 256 + (i >> 6); const int j = i & 63, ch0 = 8 * j, g = j >> 1, c0 = 8 * (j & 1);
                    const int b = (int)(tok >> 12), t = (int)(tok & (SEQ - 1));
                    const u32x4 y0 = *(const u32x4*)(YB + tok * 512 + ch0), y1 = *(const u32x4*)(YB + ((size_t)TX + tok) * 512 + ch0);
                    const u32x4 uu = *(const u32x4*)(UG + ((size_t)(b * 32 + g) * LK + LC + t) * 16 + c0);
                    const f32x4 d0 = *(const f32x4*)(a.in[25] + ch0), d1 = *(const f32x4*)(a.in[25] + ch0 + 4);
                    u32x4 w;
                    w.x = pk2(gelu_tanh(bflo(y0.x) + bflo(y1.x) + d0[0] * bflo(uu.x)), gelu_tanh(bfhi(y0.x) + bfhi(y1.x) + d0[1] * bfhi(uu.x)));
                    w.y = pk2(gelu_tanh(bflo(y0.y) + bflo(y1.y) + d0[2] * bflo(uu.y)), gelu_tanh(bfhi(y0.y) + bfhi(y1.y) + d0[3] * bfhi(uu.y)));
                    w.z = pk2(gelu_tanh(bflo(y0.z) + bflo(y1.z) + d1[0] * bflo(uu.z)), gelu_tanh(bfhi(y0.z) + bfhi(y1.z) + d1[1] * bfhi(uu.z)));
                    w.w = pk2(gelu_tanh(bflo(y0.w) + bflo(y1.w) + d1[2] * bflo(uu.w)), gelu_tanh(bfhi(y0.w) + bfhi(y1.w) + d1[3] * bfhi(uu.w)));
                    *(u32x4*)(YG + tok * 512 + ch0) = w;
                }
            }
            BSYNC();
            { pg8::SegOrder S; S.init(0, 1, pm, 1, 0, 2, 1, 0); pg8::Gemm g{YG, WGLU, 512}; EpiGlu E{YG, SX, a.in[27]}; pg8::gemm_phase<EpiGlu, false>(lds, g, S, E, wave); }
            BSYNC();
            { pg8::SegOrder S; S.init(0, 1, pm, 1, 0, 4, 1, 0); pg8::Gemm g{SX, WPS, 512}; EpiMerge<false> E{GS, MBUF}; pg8::gemm_phase<EpiMerge<false>, false>(lds, g, S, E, wave); }
            BSYNC();
            { pg8::SegOrder S; S.init(0, 1, pm, 1, 0, 4, 1, 0); pg8::Gemm g{QB, WPA, D}; EpiMerge<true> E{GA, MBUF}; pg8::gemm_phase<EpiMerge<true>, false>(lds, g, S, E, wave); }
            BSYNC();
            { pg8::SegOrder S; S.init(0, 1, pm, 1, 0, 4, 1, 0); pg8::Gemm g{MBUF, WOUT, D}; EpiResid E{X1, X1, X1, MOD + 5 * D, 1.0f}; pg8::gemm_phase<EpiResid, false>(lds, g, S, E, wave); }
            BSYNC();
            {
                const int lane = opq(lane_id()); const int mb = pm >> 4;
                f32x4 ga[4], sh[4];
#pragma unroll
                for (int j = 0; j < 4; ++j) { const int c = 4 * lane + 256 * j;
                    const f32x4 g4 = *(const f32x4*)(a.in[31] + c), sc4 = *(const f32x4*)(MOD + (size_t)mb * NMODC + 7 * D + c);
                    ga[j] = g4 * (sc4 + 1.0f); sh[j] = *(const f32x4*)(MOD + (size_t)mb * NMODC + 6 * D + c); }
                for (int rr = wave; rr < 256; rr += 8) {
                    const size_t r = (size_t)pm * 256 + rr;
                    const float* xr = X1 + r * D;
                    f32x4 v[4]; float s2 = 0.f;
#pragma unroll
                    for (int j = 0; j < 4; ++j) { v[j] = *(const f32x4*)(xr + 4 * lane + 256 * j); s2 += (v[j][0] * v[j][0] + v[j][1] * v[j][1]) + (v[j][2] * v[j][2] + v[j][3] * v[j][3]); }
                    const float rstd = rsqrtf(wave_sum(s2) * (1.f / D) + EPS);
#pragma unroll
                    for (int j = 0; j < 4; ++j) { const f32x4 y = v[j] * rstd * ga[j] + sh[j]; u32x2 w; w.x = pk2(y[0], y[1]); w.y = pk2(y[2], y[3]);
                        *(u32x2*)(GA + r * D + 4 * lane + 256 * j) = w; }
                }
            }
            if (pm + G < TX / 256) BSYNC();
        }
    }
    GSYNC(7);
#pragma unroll 1
    for (int rg = 0; rg < REPG; ++rg)
    PH(13) { pg8::SegOrder S; S.init(256, 22, 0, 0, 0, 1, G, cb); pg8::Gemm g{GA, W13_2, D}; EpiSwiglu E{ACT}; pg8::gemm_phase<EpiSwiglu, false>(lds, g, S, E, wave); }
    GSYNC(13);
    PH(14) { pg8::SegOrder S; S.init(256, 4, 0, 0, 0, 1, G, cb); pg8::Gemm g{ACT, W2_2, DFF}; EpiResid E{X1, X1, a.out, MOD + 8 * D, 0.5f}; pg8::gemm_phase<EpiResid, false>(lds, g, S, E, wave); }
}

extern "C" void kernel_launch(void* const* d_in, const int* in_sizes, int n_in, void* d_out, int out_size, void* d_ws, size_t ws_size, hipStream_t stream) {
    static int grid = 0;
    if (grid == 0) {
        if (n_in != 34 || out_size != TX * D || ws_size < WS_END) { fprintf(stderr, "kernel_launch: unexpected shapes (n_in %d, out %d, ws %zu < %zu)\n", n_in, out_size, ws_size, (size_t)WS_END); grid = -1; return; }
        int dev = 0, cus = 0, per_cu = 0;
        hipGetDevice(&dev); hipDeviceGetAttribute(&cus, hipDeviceAttributeMultiprocessorCount, dev);
        if (hipFuncSetAttribute((const void*)mega, hipFuncAttributeMaxDynamicSharedMemorySize, LDS_BYTES) != hipSuccess) { fprintf(stderr, "kernel_launch: hipFuncSetAttribute failed\n"); grid = -1; return; }
        if (hipOccupancyMaxActiveBlocksPerMultiprocessor(&per_cu, (const void*)mega, 512, LDS_BYTES) != hipSuccess || per_cu < 1) { fprintf(stderr, "kernel_launch: occupancy query says %d\n", per_cu); per_cu = 1; }
        (void)hipGetLastError();
        grid = cus;
    }
    if (grid < 0) return;
    Args a{};
    for (int i = 0; i < 34; ++i) a.in[i] = (const float*)d_in[i];
    a.out = (float*)d_out; a.ws = (unsigned char*)d_ws;
#if MK_SPLIT
    for (int p = 0; p < NPHASE; ++p) { a.ph_lo = p; a.ph_hi = p + 1; hipLaunchKernelGGL(mega, dim3(grid), dim3(512), LDS_BYTES, stream, a); }
#else
    a.ph_lo = 0; a.ph_hi = NPHASE;
    if (hipMemsetAsync((unsigned char*)d_ws + WS_BAR, 0, 256, stream) != hipSuccess) { fprintf(stderr, "kernel_launch: memset of the barrier word failed\n"); return; }
    void* args[] = {&a};
    hipError_t e = hipLaunchCooperativeKernel((const void*)mega, dim3(grid), dim3(512), args, LDS_BYTES, stream);
    if (e != hipSuccess) fprintf(stderr, "cooperative launch failed: %s (grid %d)\n", hipGetErrorString(e), grid);
#endif
}
```

```cpp
#include <hip/hip_runtime.h>
#include <hip/hip_cooperative_groups.h>
#include <cstdio>
#include <cstdint>
namespace cg = cooperative_groups;

#define LAS __attribute__((address_space(3)))
typedef unsigned short bf16_t;
typedef short bf16x8 __attribute__((ext_vector_type(8)));
typedef float f32x4 __attribute__((ext_vector_type(4)));
typedef float f32x16 __attribute__((ext_vector_type(16)));
typedef unsigned u32x4 __attribute__((ext_vector_type(4)));
typedef unsigned u32x2 __attribute__((ext_vector_type(2)));

#define DBG_ATT 1
#define REPG 1
#define REP5 1
#ifndef MK_SPLIT
#define MK_SPLIT 0
#endif

constexpr int D = 1024, NB = 16, SEQ = 4096, LC = 256, LK = SEQ + LC, TX = NB * SEQ, TC = NB * LC, TT = TX + TC;
constexpr int NH = 8, DFF = 2816, NMODC = 9 * D, NKT = LK / 64;
constexpr int NPHASE = 15;
constexpr float EPS = 1e-6f;
constexpr float QSCALE = 0.125f * 1.4426950408889634f;

constexpr size_t al256(size_t x) { return (x + 255) & ~(size_t)255; }
constexpr size_t WS_W13_1 = 0;
constexpr size_t WS_W2_1 = WS_W13_1 + (size_t)2 * DFF * D * 2;
constexpr size_t WS_WIN_M = WS_W2_1 + (size_t)D * DFF * 2;
constexpr size_t WS_WIN_V = WS_WIN_M + (size_t)4608 * D * 2;
constexpr size_t WS_WGLU = WS_WIN_V + (size_t)D * D * 2;
constexpr size_t WS_WPA = WS_WGLU + (size_t)512 * 512 * 2;
constexpr size_t WS_WPS = WS_WPA + (size_t)D * D * 2;
constexpr size_t WS_WOUT = WS_WPS + (size_t)D * 512 * 2;
constexpr size_t WS_W13_2 = WS_WOUT + (size_t)D * D * 2;
constexpr size_t WS_W2_2 = WS_W13_2 + (size_t)2 * DFF * D * 2;
constexpr size_t WS_MOD = WS_W2_2 + (size_t)D * DFF * 2;
constexpr size_t WS_ROPE = al256(WS_MOD + (size_t)17 * NMODC * 4);
constexpr size_t WS_S5A = WS_ROPE + (size_t)2 * SEQ * 32 * 4;
constexpr size_t WS_SBB = WS_S5A + (size_t)2 * 2 * 32 * 64 * 4;
constexpr size_t WS_SCM = WS_SBB + (size_t)2 * 32 * 128 * 16 * 2;
constexpr size_t WS_LAM = WS_SCM + (size_t)2 * 32 * 16 * 128 * 2;
constexpr size_t WS_BAR = WS_LAM + 256;
constexpr size_t WS_X1 = al256(WS_BAR + 256);
constexpr size_t WS_HBUF = WS_X1 + (size_t)TT * D * 4;
constexpr size_t WS_ACT = WS_HBUF + (size_t)TT * D * 2;
constexpr size_t WS_VT = WS_ACT + (size_t)TT * DFF * 2;
constexpr size_t WS_END = WS_VT + (size_t)NB * NH * LK * 128 * 2;
constexpr size_t WS_Y = WS_HBUF;
constexpr size_t WS_QB = WS_ACT;
constexpr size_t WS_KB = WS_QB + (size_t)TX * D * 2;
constexpr size_t WS_UG = WS_KB + (size_t)NB * NH * LK * 128 * 2;
constexpr size_t WS_YG = WS_KB;
constexpr size_t WS_SX = WS_KB + (size_t)TX * 512 * 2;
constexpr size_t WS_MBUF = WS_VT;
static_assert(WS_UG + (size_t)NB * 32 * LK * 16 * 2 <= WS_VT, "overlay overflow");
static_assert(WS_SX + (size_t)TX * 512 * 2 <= WS_UG, "overlay overflow");

constexpr int LDS_BYTES = 157696;

struct Args { const float* in[34]; float* out; unsigned char* ws; int ph_lo, ph_hi; };

typedef __bf16 bf16x2_t __attribute__((ext_vector_type(2)));
typedef float f32x2_t __attribute__((ext_vector_type(2)));
__device__ __forceinline__ unsigned pk2(float lo, float hi) { f32x2_t v = {lo, hi}; bf16x2_t r = __builtin_convertvector(v, bf16x2_t); return __builtin_bit_cast(unsigned, r); }
__device__ __forceinline__ float bf2f(unsigned short b) { return __uint_as_float(((unsigned)b) << 16); }
__device__ __forceinline__ float bflo(unsigned w) { return __uint_as_float(w << 16); }
__device__ __forceinline__ float bfhi(unsigned w) { return __uint_as_float(w & 0xffff0000u); }
__device__ __forceinline__ float fexp2(float x) { return __builtin_amdgcn_exp2f(x); }
__device__ __forceinline__ float frcp(float x) { return __builtin_amdgcn_rcpf(x); }
__device__ __forceinline__ float sigmoidf_(float x) { return frcp(1.f + fexp2(-1.4426950408889634f * x)); }
__device__ __forceinline__ float siluf_(float x) { return x * sigmoidf_(x); }
__device__ __forceinline__ float gelu_tanh(float x) { const float u = 0.7978845608028654f * (x + 0.044715f * x * x * x); return x * sigmoidf_(2.f * u); }
__device__ __forceinline__ float wave_sum(float v) {
#pragma unroll
    for (int o = 1; o < 64; o <<= 1) v += __shfl_xor(v, o);
    return v;
}
__device__ __forceinline__ int opq(int x) { asm volatile("" : "+v"(x)); return x; }
__device__ __forceinline__ int lane_id() { return (int)__builtin_amdgcn_mbcnt_hi(~0u, __builtin_amdgcn_mbcnt_lo(~0u, 0u)); }
#define LDS_WAIT() asm volatile("s_waitcnt lgkmcnt(0)" ::: "memory")
#define CFENCE() asm volatile("" ::: "memory")

namespace pg8 {
constexpr int BM = 256, BK = 64, HALF = 128, HTB = HALF * BK * 2, STAGE_BYTES = 8 * HTB, NXCD = 8, WGM = 8;
__host__ __device__ __forceinline__ int lds_byte(int r, int c) { const int st = (r >> 4) * 2 + (c >> 5), rr = r & 15, cc = c & 31, ob = rr * 64 + cc * 2; return st * 1024 + (ob ^ (((ob >> 9) & 1) << 5)); }
__host__ __device__ __forceinline__ void stage_rc(int b, int& R, int& C) { const int st = b / 1024, sb = b % 1024, swz = sb ^ (((sb >> 9) & 1) << 5); R = (st >> 1) * 16 + swz / 64; C = (st & 1) * 32 + (swz % 64) / 2; }
__host__ __device__ __forceinline__ int perm32(int rho) { const int n = rho >> 4, i = rho & 15; return 8 * (i >> 2) + 4 * n + (i & 3); }
struct Unit { int pm, pn; };
struct Gemm { const bf16_t* A; const bf16_t* Bt; int K; };

struct SegOrder {
    int nM1, nN1, n1, pm2, nM2, pn2, nN2, n2, G, c;
    __device__ __forceinline__ void init(int nM1_, int nN1_, int pm2_, int nM2_, int pn2_, int nN2_, int G_, int c_) {
        nM1 = nM1_; nN1 = nN1_; n1 = nM1 * nN1; pm2 = pm2_; nM2 = nM2_; pn2 = pn2_; nN2 = nN2_; n2 = nM2 * nN2; G = G_; c = c_; }
    __device__ __forceinline__ bool next(int i, Unit& u) const {
        long L = (long)i * G + c;
        if (L < n1) {
            int wgid = (int)L; { const int q = n1 / NXCD, r = n1 % NXCD, xcd = wgid % NXCD, off = wgid / NXCD; wgid = (xcd < r ? xcd * (q + 1) : r * (q + 1) + (xcd - r) * q) + off; }
            const int nig = WGM * nN1, gid = wgid / nig, fm = gid * WGM, gsz = (nM1 - fm) < WGM ? (nM1 - fm) : WGM;
            u.pm = fm + ((wgid % nig) % gsz); u.pn = (wgid % nig) / gsz; return true;
        }
        L -= n1; if (L >= n2) return false;
        u.pm = pm2 + (int)(L / nN2); u.pn = pn2 + (int)(L % nN2); return true;
    }
};

template <class Epi, bool SWAP>
__device__ __forceinline__ void gemm_phase(LAS unsigned char* lds, const Gemm g, const SegOrder& S, const Epi& E, int wid) {
    const int lane = opq(lane_id()), tid = wid * 64 + lane, wr = wid >> 2, wc = wid & 3, fr = lane & 15, fq = lane >> 4;
    const int K = g.K, nt = K / BK;
    unsigned voffA[2], voffB[2];
#pragma unroll
    for (int i = 0; i < 2; ++i) { int R, C; stage_rc(tid * 16 + i * 8192, R, C); const int Rb = Epi::PERM ? ((R & ~31) + perm32(R & 31)) : R;
        voffA[i] = (unsigned)(R * K + C) * 2u; voffB[i] = (unsigned)(Rb * K + C) * 2u; }
    const size_t kstep = (size_t)(BK * 2);
    const size_t hstep = (size_t)HALF * K * 2;
    const size_t tstep = 2 * hstep;
    const unsigned ldsw = (unsigned)wid * 1024u;
    const int aoff = lds_byte(wr * 64 + fr, fq * 8), boff = lds_byte(wc * 32 + fr, fq * 8);
#define PG8_SA(b, h) (((b) * 2 + (h)) * HTB)
#define PG8_SB(b, h) ((4 + (b) * 2 + (h)) * HTB)
#define PG8_STAGE(bufoff, gbase, voff) do { _Pragma("unroll") for (int _i = 0; _i < 2; ++_i) \
        __builtin_amdgcn_global_load_lds((const unsigned*)((const char*)(gbase) + (voff)[_i]), (LAS unsigned*)(lds + (bufoff) + ldsw + _i * 8192), 16, 0, 0); } while (0)
#define PG8_LDA(dst, b, h) do { _Pragma("unroll") for (int m = 0; m < 4; ++m) _Pragma("unroll") for (int k = 0; k < 2; ++k) dst[m][k] = *(const LAS bf16x8*)(lds + PG8_SA(b, h) + aoff + m * 2048 + k * 1024); } while (0)
#define PG8_LDB(dst, b, h) do { _Pragma("unroll") for (int n = 0; n < 2; ++n) _Pragma("unroll") for (int k = 0; k < 2; ++k) dst[n][k] = *(const LAS bf16x8*)(lds + PG8_SB(b, h) + boff + n * 2048 + k * 1024); } while (0)
#define PG8_MMA(ai, bj, At, Bt) do { __builtin_amdgcn_s_setprio(1); _Pragma("unroll") for (int m = 0; m < 4; ++m) _Pragma("unroll") for (int n = 0; n < 2; ++n) _Pragma("unroll") for (int k = 0; k < 2; ++k) \
        acc[ai][bj][m][n] = SWAP ? __builtin_amdgcn_mfma_f32_16x16x32_bf16(At[m][k], Bt[n][k], acc[ai][bj][m][n], 0, 0, 0) \
                                 : __builtin_amdgcn_mfma_f32_16x16x32_bf16(Bt[n][k], At[m][k], acc[ai][bj][m][n], 0, 0, 0); __builtin_amdgcn_s_setprio(0); } while (0)
#define PG8_WAIT_V(n) asm volatile("s_waitcnt vmcnt(" #n ")" ::: "memory")
#define PG8_WAIT_L(n) asm volatile("s_waitcnt lgkmcnt(" #n ")" ::: "memory")
#define PG8_BAR __builtin_amdgcn_s_barrier()
#define PG8_SCHED __builtin_amdgcn_sched_barrier(0)
    Unit cur, nxt; int ui = 0;
    if (!S.next(0, cur)) return;
    f32x4 acc[2][2][4][2];
#pragma unroll
    for (int a = 0; a < 2; ++a)
#pragma unroll
        for (int b = 0; b < 2; ++b)
#pragma unroll
            for (int m = 0; m < 4; ++m)
#pragma unroll
                for (int n = 0; n < 2; ++n) acc[a][b][m][n] = (f32x4){0.f, 0.f, 0.f, 0.f};
    bf16x8 At[4][2], B0[2][2], B1[2][2];
    const char* cA = (const char*)g.A + (size_t)cur.pm * tstep; const char* cB = (const char*)g.Bt + (size_t)cur.pn * tstep;
    PG8_STAGE(PG8_SB(0, 0), cB, voffB); PG8_STAGE(PG8_SB(0, 1), cB + hstep, voffB); PG8_STAGE(PG8_SA(0, 0), cA, voffA); PG8_STAGE(PG8_SA(0, 1), cA + hstep, voffA);
    if (wr == 1) PG8_BAR;
    PG8_WAIT_V(2); PG8_BAR;
    PG8_STAGE(PG8_SB(1, 0), cB + kstep, voffB); PG8_STAGE(PG8_SA(1, 0), cA + kstep, voffA); PG8_STAGE(PG8_SB(1, 1), cB + hstep + kstep, voffB);
    PG8_WAIT_V(6); PG8_BAR;
    for (;;) {
        const bool has_next = S.next(ui + 1, nxt);
        const char* nA = has_next ? (const char*)g.A + (size_t)nxt.pm * tstep : cA; const char* nB = has_next ? (const char*)g.Bt + (size_t)nxt.pn * tstep : cB;
        for (int t = 0; t < nt; t += 2) {
            const bool last = (t == nt - 2);
            const char* a1 = cA + (size_t)(t + 1) * kstep;
            const char* a2 = last ? nA : cA + (size_t)(t + 2) * kstep; const char* b2 = last ? nB : cB + (size_t)(t + 2) * kstep;
            const char* a3 = a2 + kstep; const char* b3 = b2 + kstep;
            PG8_LDB(B0, 0, 0); PG8_LDB(B1, 0, 1); PG8_SCHED; PG8_LDA(At, 0, 0); PG8_STAGE(PG8_SA(1, 1), a1 + hstep, voffA);
            PG8_WAIT_V(8); PG8_WAIT_L(0); PG8_BAR; PG8_MMA(0, 0, At, B0); PG8_MMA(0, 1, At, B1); PG8_BAR; PG8_SCHED;
            PG8_LDA(At, 0, 1); PG8_STAGE(PG8_SB(0, 0), b2, voffB); PG8_STAGE(PG8_SB(0, 1), b2 + hstep, voffB); PG8_STAGE(PG8_SA(0, 0), a2, voffA);
            PG8_WAIT_V(8); PG8_WAIT_L(0); PG8_BAR; PG8_MMA(1, 0, At, B0); PG8_MMA(1, 1, At, B1); PG8_BAR; PG8_SCHED;
            PG8_LDB(B0, 1, 0); PG8_LDB(B1, 1, 1); PG8_SCHED; PG8_LDA(At, 1, 0); PG8_STAGE(PG8_SA(0, 1), a2 + hstep, voffA);
            PG8_WAIT_V(8); PG8_WAIT_L(0); PG8_BAR; PG8_MMA(0, 0, At, B0); PG8_MMA(0, 1, At, B1); PG8_BAR; PG8_SCHED;
            PG8_LDA(At, 1, 1); PG8_STAGE(PG8_SB(1, 0), b3, voffB); PG8_STAGE(PG8_SB(1, 1), b3 + hstep, voffB); PG8_STAGE(PG8_SA(1, 0), a3, voffA);
            PG8_WAIT_V(8); PG8_WAIT_L(0); PG8_BAR; PG8_MMA(1, 0, At, B0); PG8_MMA(1, 1, At, B1); PG8_BAR; PG8_SCHED;
        }
        if (wr == 0) PG8_BAR;
        E(acc, cur, wr, wc, fr, fq);
        if (!has_next) break;
#pragma unroll
        for (int a = 0; a < 2; ++a)
#pragma unroll
            for (int b = 0; b < 2; ++b)
#pragma unroll
                for (int m = 0; m < 4; ++m)
#pragma unroll
                    for (int n = 0; n < 2; ++n) acc[a][b][m][n] = (f32x4){0.f, 0.f, 0.f, 0.f};
        cur = nxt; cA = nA; cB = nB; ++ui;
        if (wr == 1) PG8_BAR;
    }
    PG8_WAIT_V(0);
    PG8_BAR;
#undef PG8_SA
#undef PG8_SB
#undef PG8_STAGE
#undef PG8_LDA
#undef PG8_LDB
#undef PG8_MMA
#undef PG8_WAIT_V
#undef PG8_WAIT_L
#undef PG8_BAR
#undef PG8_SCHED
}
}
using pg8::Unit;


struct EpiSwiglu {
    static constexpr bool PERM = true;
    bf16_t* O;
    __device__ __forceinline__ void operator()(const f32x4 (&acc)[2][2][4][2], const Unit& u, int wr, int wc, int fr, int fq) const {
        const int row0 = u.pm * 256 + wr * 64 + fr, col0 = u.pn * 128 + wc * 32 + 8 * fq;
#pragma unroll
        for (int ai = 0; ai < 2; ++ai)
#pragma unroll
            for (int m = 0; m < 4; ++m) {
                const f32x4 a0 = acc[ai][0][m][0], a1 = acc[ai][0][m][1], b0 = acc[ai][1][m][0], b1 = acc[ai][1][m][1];
                u32x4 w;
                w.x = pk2(siluf_(a0[0]) * b0[0], siluf_(a0[1]) * b0[1]); w.y = pk2(siluf_(a0[2]) * b0[2], siluf_(a0[3]) * b0[3]);
                w.z = pk2(siluf_(a1[0]) * b1[0], siluf_(a1[1]) * b1[1]); w.w = pk2(siluf_(a1[2]) * b1[2], siluf_(a1[3]) * b1[3]);
                *(u32x4*)(O + (size_t)(row0 + ai * 128 + m * 16) * DFF + col0) = w;
            }
    }
};

struct EpiResid {
    static constexpr bool PERM = false;
    const float* srcX; const float* srcC; float* dst; const float* gate; float coef;
    __device__ __forceinline__ void operator()(const f32x4 (&acc)[2][2][4][2], const Unit& u, int wr, int wc, int fr, int fq) const {
        const int mb = u.pm < 256 ? (u.pm >> 4) : 16;
        const float* sp = u.pm < 256 ? srcX + (size_t)u.pm * 256 * D : srcC + (size_t)(u.pm - 256) * 256 * D;
        float* dp = dst + (size_t)u.pm * 256 * D;
        const int rl = wr * 64 + fr, col0 = u.pn * 256 + wc * 32 + 4 * fq;
        f32x4 gv[2][2];
#pragma unroll
        for (int bj = 0; bj < 2; ++bj)
#pragma unroll
            for (int n = 0; n < 2; ++n) gv[bj][n] = *(const f32x4*)(gate + (size_t)mb * NMODC + col0 + bj * 128 + n * 16) * coef;
#pragma unroll
        for (int ai = 0; ai < 2; ++ai)
#pragma unroll
            for (int m = 0; m < 4; ++m) {
                const size_t ro = (size_t)(rl + ai * 128 + m * 16) * D + col0;
#pragma unroll
                for (int bj = 0; bj < 2; ++bj)
#pragma unroll
                    for (int n = 0; n < 2; ++n) { const f32x4 s = *(const f32x4*)(sp + ro + bj * 128 + n * 16); *(f32x4*)(dp + ro + bj * 128 + n * 16) = s + gv[bj][n] * acc[ai][bj][m][n]; }
            }
    }
};

struct EpiInMain {
    static constexpr bool PERM = true;
    bf16_t* QB; bf16_t* KB; bf16_t* UG; bf16_t* GA; bf16_t* GS; const float* qn; const float* kn; const float* ropec; const float* ropes;
    __device__ __forceinline__ void operator()(const f32x4 (&acc)[2][2][4][2], const Unit& u, int wr, int wc, int fr, int fq) const {
        const int pn = u.pn; const bool isx = u.pm < 256;
        const int rl = wr * 64 + fr;
        if (pn < 8) {
            const bool isq = pn < 4;
            const float* gn = isq ? qn : kn;
            f32x4 g[2][2];
#pragma unroll
            for (int bj = 0; bj < 2; ++bj)
#pragma unroll
                for (int n = 0; n < 2; ++n) g[bj][n] = *(const f32x4*)(gn + 32 * bj + 8 * fq + 4 * n);
            const int hcg = 4 * (pn & 3) + wc, head = hcg >> 1, comp = hcg & 1;
#pragma unroll
            for (int ai = 0; ai < 2; ++ai)
#pragma unroll
                for (int m = 0; m < 4; ++m) {
                    const int r = u.pm * 256 + rl + ai * 128 + m * 16;
                    f32x4 v[2][2]; float ss = 0.f;
#pragma unroll
                    for (int bj = 0; bj < 2; ++bj)
#pragma unroll
                        for (int n = 0; n < 2; ++n) { v[bj][n] = acc[ai][bj][m][n]; ss += (v[bj][n][0] * v[bj][n][0] + v[bj][n][1] * v[bj][n][1]) + (v[bj][n][2] * v[bj][n][2] + v[bj][n][3] * v[bj][n][3]); }
                    ss += __shfl_xor(ss, 16); ss += __shfl_xor(ss, 32);
                    const float rstd = rsqrtf(ss * (1.f / 64.f) + EPS);
#pragma unroll
                    for (int bj = 0; bj < 2; ++bj)
#pragma unroll
                        for (int n = 0; n < 2; ++n) v[bj][n] = v[bj][n] * rstd * g[bj][n];
                    if (isx) {
                        const int t = r & (SEQ - 1);
#pragma unroll
                        for (int n = 0; n < 2; ++n) {
                            const f32x4 cs = *(const f32x4*)(ropec + t * 32 + 8 * fq + 4 * n), sn = *(const f32x4*)(ropes + t * 32 + 8 * fq + 4 * n);
                            const f32x4 t1 = v[0][n], t2 = v[1][n];
                            v[0][n] = t1 * cs - t2 * sn; v[1][n] = t2 * cs + t1 * sn;
                        }
                    }
                    bf16_t* dstp;
                    if (isq) {
#pragma unroll
                        for (int bj = 0; bj < 2; ++bj)
#pragma unroll
                            for (int n = 0; n < 2; ++n) v[bj][n] = v[bj][n] * QSCALE;
                        dstp = QB + (size_t)r * D + hcg * 64 + 8 * fq;
                    } else {
                        int b, pos; if (isx) { b = r >> 12; pos = LC + (r & (SEQ - 1)); } else { const int rc = r - TX; b = rc >> 8; pos = rc & (LC - 1); }
                        dstp = KB + (((size_t)(b * NH + head) * LK + pos) * 2 + comp) * 64 + 8 * fq;
                    }
#pragma unroll
                    for (int bj = 0; bj < 2; ++bj) {
                        u32x4 w; w.x = pk2(v[bj][0][0], v[bj][0][1]); w.y = pk2(v[bj][0][2], v[bj][0][3]); w.z = pk2(v[bj][1][0], v[bj][1][1]); w.w = pk2(v[bj][1][2], v[bj][1][3]);
                        *(u32x4*)(dstp + 32 * bj) = w;
                    }
                }
        } else if (pn < 10) {
#pragma unroll
            for (int ai = 0; ai < 2; ++ai)
#pragma unroll
                for (int m = 0; m < 4; ++m) {
                    const int r = u.pm * 256 + rl + ai * 128 + m * 16;
                    int b, pos; if (isx) { b = r >> 12; pos = LC + (r & (SEQ - 1)); } else { const int rc = r - TX; b = rc >> 8; pos = rc & (LC - 1); }
#pragma unroll
                    for (int bj = 0; bj < 2; ++bj) {
                        const int ch0 = 256 * (pn - 8) + 128 * bj + 32 * wc + 8 * fq, gidx = ch0 >> 4, c0 = ch0 & 15;
                        const f32x4 v0 = acc[ai][bj][m][0], v1 = acc[ai][bj][m][1];
                        u32x4 w; w.x = pk2(v0[0], v0[1]); w.y = pk2(v0[2], v0[3]); w.z = pk2(v1[0], v1[1]); w.w = pk2(v1[2], v1[3]);
                        *(u32x4*)(UG + ((size_t)(b * 32 + gidx) * LK + pos) * 16 + c0) = w;
                    }
                }
        } else {
            bf16_t* Gd = pn < 14 ? GA : GS; const int pq = pn < 14 ? pn - 10 : pn - 14;
#pragma unroll
            for (int ai = 0; ai < 2; ++ai)
#pragma unroll
                for (int m = 0; m < 4; ++m) {
                    const int r = u.pm * 256 + rl + ai * 128 + m * 16;
#pragma unroll
                    for (int bj = 0; bj < 2; ++bj) {
                        const f32x4 v0 = acc[ai][bj][m][0], v1 = acc[ai][bj][m][1];
                        u32x4 w; w.x = pk2(sigmoidf_(v0[0]), sigmoidf_(v0[1])); w.y = pk2(sigmoidf_(v0[2]), sigmoidf_(v0[3])); w.z = pk2(sigmoidf_(v1[0]), sigmoidf_(v1[1])); w.w = pk2(sigmoidf_(v1[2]), sigmoidf_(v1[3]));
                        *(u32x4*)(Gd + (size_t)r * D + 256 * pq + 128 * bj + 32 * wc + 8 * fq) = w;
                    }
                }
        }
    }
};

struct EpiInV {
    static constexpr bool PERM = false;
    bf16_t* VT;
    __device__ __forceinline__ void operator()(const f32x4 (&acc)[2][2][4][2], const Unit& u, int wr, int wc, int fr, int fq) const {
        const bool isx = u.pm < 256;
#pragma unroll
        for (int ai = 0; ai < 2; ++ai)
#pragma unroll
            for (int m = 0; m < 4; ++m) {
                const int r = u.pm * 256 + ai * 128 + wr * 64 + m * 16 + 4 * fq;
                int b, pos; if (isx) { b = r >> 12; pos = LC + (r & (SEQ - 1)); } else { const int rc = r - TX; b = rc >> 8; pos = rc & (LC - 1); }
                const int tile = pos >> 6, kp = pos & 63, k16 = kp & 15, sp = (kp & 48) + 8 * ((k16 >> 2) & 1) + 4 * (k16 >> 3);
#pragma unroll
                for (int bj = 0; bj < 2; ++bj)
#pragma unroll
                    for (int n = 0; n < 2; ++n) {
                        const int col = u.pn * 256 + bj * 128 + wc * 32 + n * 16 + fr, h = col >> 7, dv = col & 127;
                        const f32x4 v = acc[ai][bj][m][n];
                        u32x2 w; w.x = pk2(v[0], v[1]); w.y = pk2(v[2], v[3]);
                        *(u32x2*)(VT + (((size_t)(b * NH + h) * NKT + tile) * 128 + dv) * 64 + sp) = w;
                    }
            }
    }
};

struct EpiGlu {
    static constexpr bool PERM = true;
    const bf16_t* YG; bf16_t* SX; const float* bglu;
    __device__ __forceinline__ void operator()(const f32x4 (&acc)[2][2][4][2], const Unit& u, int wr, int wc, int fr, int fq) const {
        const int row0 = u.pm * 256 + wr * 64 + fr, col0 = u.pn * 256 + wc * 32 + 8 * fq;
#pragma unroll
        for (int bj = 0; bj < 2; ++bj) {
            const f32x4 bv0 = *(const f32x4*)(bglu + col0 + bj * 128), bv1 = *(const f32x4*)(bglu + col0 + bj * 128 + 4);
#pragma unroll
            for (int ai = 0; ai < 2; ++ai)
#pragma unroll
                for (int m = 0; m < 4; ++m) {
                    const size_t o = (size_t)(row0 + ai * 128 + m * 16) * 512 + col0 + bj * 128;
                    const u32x4 y = *(const u32x4*)(YG + o);
                    const f32x4 v0 = acc[ai][bj][m][0] + bv0, v1 = acc[ai][bj][m][1] + bv1;
                    u32x4 w;
                    w.x = pk2(bflo(y.x) * sigmoidf_(v0[0]), bfhi(y.x) * sigmoidf_(v0[1])); w.y = pk2(bflo(y.y) * sigmoidf_(v0[2]), bfhi(y.y) * sigmoidf_(v0[3]));
                    w.z = pk2(bflo(y.z) * sigmoidf_(v1[0]), bfhi(y.z) * sigmoidf_(v1[1])); w.w = pk2(bflo(y.w) * sigmoidf_(v1[2]), bfhi(y.w) * sigmoidf_(v1[3]));
                    *(u32x4*)(SX + o) = w;
                }
        }
    }
};

template <bool ACCUM> struct EpiMerge {
    static constexpr bool PERM = true;
    const bf16_t* Gt; bf16_t* Mb;
    __device__ __forceinline__ void operator()(const f32x4 (&acc)[2][2][4][2], const Unit& u, int wr, int wc, int fr, int fq) const {
        const int row0 = u.pm * 256 + wr * 64 + fr, col0 = u.pn * 256 + wc * 32 + 8 * fq;
#pragma unroll
        for (int ai = 0; ai < 2; ++ai)
#pragma unroll
            for (int m = 0; m < 4; ++m)
#pragma unroll
                for (int bj = 0; bj < 2; ++bj) {
                    const size_t o = (size_t)(row0 + ai * 128 + m * 16) * D + col0 + bj * 128;
                    const u32x4 gt = *(const u32x4*)(Gt + o);
                    const f32x4 v0 = acc[ai][bj][m][0], v1 = acc[ai][bj][m][1];
                    float r0 = bflo(gt.x) * v0[0], r1 = bfhi(gt.x) * v0[1], r2 = bflo(gt.y) * v0[2], r3 = bfhi(gt.y) * v0[3];
                    float r4 = bflo(gt.z) * v1[0], r5 = bfhi(gt.z) * v1[1], r6 = bflo(gt.w) * v1[2], r7 = bfhi(gt.w) * v1[3];
                    if (ACCUM) { const u32x4 p = *(const u32x4*)(Mb + o);
                        r0 += bflo(p.x); r1 += bfhi(p.x); r2 += bflo(p.y); r3 += bfhi(p.y); r4 += bflo(p.z); r5 += bfhi(p.z); r6 += bflo(p.w); r7 += bfhi(p.w); }
                    u32x4 w; w.x = pk2(r0, r1); w.y = pk2(r2, r3); w.z = pk2(r4, r5); w.w = pk2(r6, r7);
                    *(u32x4*)(Mb + o) = w;
                }
    }
};

__device__ __forceinline__ void tr_item(const float* W, int K, int N, int k0, int scol0, bf16_t* WT, int drow0, LAS float* scr, int lane) {
#pragma unroll 8
    for (int i = 0; i < 32; ++i) { const int kk = 2 * i + (lane >> 5); scr[kk * 33 + (lane & 31)] = W[(size_t)(k0 + kk) * N + scol0 + (lane & 31)]; }
    LDS_WAIT();
    const int c = lane & 7;
#pragma unroll
    for (int j = 0; j < 4; ++j) { const int n = (lane >> 3) + 8 * j; const LAS float* s = scr + (8 * c) * 33 + n;
        u32x4 o; o.x = pk2(s[0 * 33], s[1 * 33]); o.y = pk2(s[2 * 33], s[3 * 33]); o.z = pk2(s[4 * 33], s[5 * 33]); o.w = pk2(s[6 * 33], s[7 * 33]);
        *(u32x4*)(WT + (size_t)(drow0 + n) * K + k0 + 8 * c) = o; }
    LDS_WAIT();
}
__device__ __forceinline__ int src_w13(int n0) { const int pn = n0 >> 8, s = n0 & 255; return (s >> 7) * DFF + 128 * pn + (s & 127); }
__device__ __forceinline__ int src_winm(int n0) {
    if (n0 < 2048) { const int base = n0 < 1024 ? 0 : 1024, nn = n0 - base, pn = nn >> 8, s = nn & 255, bj = s >> 7, wc = (s & 127) >> 5, hcg = 4 * pn + wc; return base + hcg * 64 + 32 * bj; }
    if (n0 < 2560) return 3072 + (n0 - 2048);
    return 3584 + (n0 - 2560);
}

__global__ void __launch_bounds__(512, 2) mega(Args a) {
    extern __shared__ __attribute__((aligned(16))) unsigned char smem[];
    LAS unsigned char* lds = (LAS unsigned char*)smem;
    const int wave = __builtin_amdgcn_readfirstlane(threadIdx.x >> 6);
    const int G = gridDim.x, cb = blockIdx.x;
    const int gw = cb * 8 + wave, NW = G * 8;
    unsigned char* ws = a.ws;
    bf16_t* W13_1 = (bf16_t*)(ws + WS_W13_1); bf16_t* W2_1 = (bf16_t*)(ws + WS_W2_1); bf16_t* WINM = (bf16_t*)(ws + WS_WIN_M); bf16_t* WINV = (bf16_t*)(ws + WS_WIN_V);
    bf16_t* WGLU = (bf16_t*)(ws + WS_WGLU); bf16_t* WPA = (bf16_t*)(ws + WS_WPA); bf16_t* WPS = (bf16_t*)(ws + WS_WPS); bf16_t* WOUT = (bf16_t*)(ws + WS_WOUT);
    bf16_t* W13_2 = (bf16_t*)(ws + WS_W13_2); bf16_t* W2_2 = (bf16_t*)(ws + WS_W2_2);
    float* MOD = (float*)(ws + WS_MOD); float* ROPEC = (float*)(ws + WS_ROPE); float* ROPES = ROPEC + SEQ * 32;
    float* S5AR = (float*)(ws + WS_S5A); float* S5AI = S5AR + 2 * 32 * 64; bf16_t* SBB = (bf16_t*)(ws + WS_SBB); bf16_t* SCM = (bf16_t*)(ws + WS_SCM); float* LAMP = (float*)(ws + WS_LAM);
    float* X1 = (float*)(ws + WS_X1); bf16_t* HBUF = (bf16_t*)(ws + WS_HBUF); bf16_t* ACT = (bf16_t*)(ws + WS_ACT); bf16_t* VT = (bf16_t*)(ws + WS_VT);
    bf16_t* YB = (bf16_t*)(ws + WS_Y); bf16_t* QB = (bf16_t*)(ws + WS_QB); bf16_t* KB = (bf16_t*)(ws + WS_KB); bf16_t* UG = (bf16_t*)(ws + WS_UG);
    bf16_t* YG = (bf16_t*)(ws + WS_YG); bf16_t* SX = (bf16_t*)(ws + WS_SX); bf16_t* MBUF = (bf16_t*)(ws + WS_MBUF);
    bf16_t* GA = (bf16_t*)a.out; bf16_t* GS = GA + (size_t)TX * D;
    const float* Xin = a.in[0]; const float* Cin = a.in[2];

#ifndef PHMASK
#define PHMASK 0x7fff
#endif
#define PH(n) if (((PHMASK >> (n)) & 1) && a.ph_lo <= (n) && (n) < a.ph_hi)
#if MK_SPLIT
#define GSYNC(n) do { } while (0)
#else
#define GSYNC(n) do { if (a.ph_lo <= (n) && (n) + 1 < a.ph_hi) { bar_t += (unsigned)G; \
        asm volatile("s_waitcnt vmcnt(0) lgkmcnt(0)" ::: "memory");       \
        __syncthreads(); \
        if (wave == 0) {                                                   \
            __builtin_amdgcn_fence(__ATOMIC_RELEASE, "agent"); asm volatile("s_waitcnt vmcnt(0)" ::: "memory"); \
            if (lane_id() == 0) { __hip_atomic_fetch_add(BARW, 1u, __ATOMIC_RELAXED, __HIP_MEMORY_SCOPE_AGENT); \
                while (__hip_atomic_load(BARW, __ATOMIC_RELAXED, __HIP_MEMORY_SCOPE_AGENT) < bar_t) __builtin_amdgcn_s_sleep(1); } \
            __builtin_amdgcn_fence(__ATOMIC_ACQUIRE, "agent"); asm volatile("s_waitcnt vmcnt(0) lgkmcnt(0)" ::: "memory"); } \
        __syncthreads(); } } while (0)
#endif
    unsigned* BARW = (unsigned*)(ws + WS_BAR); unsigned bar_t = 0;
#if !MK_SPLIT
    if (a.ph_lo == 0) cg::this_grid().sync();
#endif

    PH(0) {
        const int lane = opq(lane_id()), tid = wave * 64 + lane;
        for (int slab = cb; slab < NMODC / 64; slab += G) {
            LAS float* sl = (LAS float*)lds;
            LAS float* red = (LAS float*)(lds + 17 * 1024 * 4);
            for (int i = tid; i < 17 * 1024; i += 512) { const int mb = i >> 10, k = i & 1023; const float v = mb < 16 ? a.in[1][mb * 1024 + k] : a.in[3][k]; sl[i] = siluf_(v); }
            __syncthreads();
            float accm[17];
#pragma unroll
            for (int j = 0; j < 17; ++j) accm[j] = 0.f;
            const float* wp = a.in[4] + (size_t)(wave * 128) * NMODC + slab * 64 + lane;
#pragma unroll 4
            for (int k = 0; k < 128; ++k) { const float w = wp[(size_t)k * NMODC];
#pragma unroll
                for (int j = 0; j < 17; ++j) accm[j] += w * sl[j * 1024 + wave * 128 + k]; }
#pragma unroll
            for (int j = 0; j < 17; ++j) red[(wave * 17 + j) * 64 + lane] = accm[j];
            __syncthreads();
            for (int i = tid; i < 17 * 64; i += 512) { const int j = i >> 6, l = i & 63; float s = a.in[5][slab * 64 + l];
#pragma unroll
                for (int w = 0; w < 8; ++w) s += red[(w * 17 + j) * 64 + l];
                MOD[(size_t)j * NMODC + slab * 64 + l] = s; }
            __syncthreads();
        }
        {
            LAS float* scr = (LAS float*)(lds + wave * 16384);
            constexpr int I13 = 16 * 176, I2 = 44 * 32, IINM = 16 * 144, IINV = 16 * 32, IGLU = 8 * 16, IPA = 16 * 32, IPS = 8 * 32, IOUT = 16 * 32;
            constexpr int NIT = 2 * I13 + 2 * I2 + IINM + IINV + IGLU + IPA + IPS + IOUT;
            for (int it = gw; it < NIT; it += NW) {
                int r = it;
                if (r < I13) { const int kb = r / 176, nb = r % 176; tr_item(a.in[7], D, 2 * DFF, 64 * kb, src_w13(32 * nb), W13_1, 32 * nb, scr, lane); continue; } r -= I13;
                if (r < I13) { const int kb = r / 176, nb = r % 176; tr_item(a.in[32], D, 2 * DFF, 64 * kb, src_w13(32 * nb), W13_2, 32 * nb, scr, lane); continue; } r -= I13;
                if (r < I2) { const int kb = r / 32, nb = r % 32; tr_item(a.in[8], DFF, D, 64 * kb, 32 * nb, W2_1, 32 * nb, scr, lane); continue; } r -= I2;
                if (r < I2) { const int kb = r / 32, nb = r % 32; tr_item(a.in[33], DFF, D, 64 * kb, 32 * nb, W2_2, 32 * nb, scr, lane); continue; } r -= I2;
                if (r < IINM) { const int kb = r / 144, nb = r % 144; tr_item(a.in[10], D, 5632, 64 * kb, src_winm(32 * nb), WINM, 32 * nb, scr, lane); continue; } r -= IINM;
                if (r < IINV) { const int kb = r / 32, nb = r % 32; tr_item(a.in[10], D, 5632, 64 * kb, 2048 + 32 * nb, WINV, 32 * nb, scr, lane); continue; } r -= IINV;
                if (r < IGLU) { const int kb = r / 16, nb = r % 16; tr_item(a.in[26], 512, 512, 64 * kb, 32 * nb, WGLU, 32 * nb, scr, lane); continue; } r -= IGLU;
                if (r < IPA) { const int kb = r / 32, nb = r % 32; tr_item(a.in[28], D, D, 64 * kb, 32 * nb, WPA, 32 * nb, scr, lane); continue; } r -= IPA;
                if (r < IPS) { const int kb = r / 32, nb = r % 32; tr_item(a.in[29], 512, D, 64 * kb, 32 * nb, WPS, 32 * nb, scr, lane); continue; } r -= IPS;
                { const int kb = r / 32, nb = r % 32; tr_item(a.in[30], D, D, 64 * kb, 32 * nb, WOUT, 32 * nb, scr, lane); }
            }
        }
        for (int i = cb * 512 + tid; i < SEQ * 32; i += G * 512) {
            const int t = i >> 5, f = i & 31; const int pos = f < 16 ? (t >> 6) : (t & 63); const int fi = f & 15;
            const float inv = (float)pow(10000.0, -(double)fi / 16.0); const float ang = (float)pos * inv;
            ROPEC[i] = (float)cos((double)ang); ROPES[i] = (float)sin((double)ang);
        }
        for (int i = cb * 512 + tid; i < 2 * 32 * 64; i += G * 512) {
            const int dg = i >> 6, p = i & 63;
            const double lre = a.in[18][i], lim = a.in[19][i], dt = exp((double)a.in[20][dg]);
            const double mag = exp(lre * dt), ar = mag * cos(lim * dt), ai = mag * sin(lim * dt), den = lre * lre + lim * lim, nr = ar - 1.0;
            const double fr_ = (nr * lre + ai * lim) / den, fi_ = (ai * lre - nr * lim) / den;
            S5AR[i] = (float)ar; S5AI[i] = (float)ai;
            const float* bre = a.in[21] + (size_t)i * 16; const float* bim = a.in[22] + (size_t)i * 16;
#pragma unroll
            for (int c2 = 0; c2 < 16; c2 += 2) {
                const double r0 = fr_ * bre[c2] - fi_ * bim[c2], r1 = fr_ * bre[c2 + 1] - fi_ * bim[c2 + 1], i0 = fr_ * bim[c2] + fi_ * bre[c2], i1 = fr_ * bim[c2 + 1] + fi_ * bre[c2 + 1];
                *(unsigned*)(SBB + ((size_t)dg * 128 + 2 * p) * 16 + c2) = pk2((float)r0, (float)r1);
                *(unsigned*)(SBB + ((size_t)dg * 128 + 2 * p + 1) * 16 + c2) = pk2((float)i0, (float)i1);
            }
        }
        for (int i = cb * 512 + tid; i < 2 * 32 * 16 * 64; i += G * 512) {
            const int p2 = (i & 31) * 2, dgc = i >> 5;
            if (i < 2 * 32 * 16 * 32) {
                const float* cre = a.in[23] + (size_t)dgc * 64; const float* cim = a.in[24] + (size_t)dgc * 64;
                *(unsigned*)(SCM + (size_t)dgc * 128 + 2 * p2) = pk2(cre[p2], -cim[p2]);
                *(unsigned*)(SCM + (size_t)dgc * 128 + 2 * p2 + 2) = pk2(cre[p2 + 1], -cim[p2 + 1]);
            }
        }
        if (cb == 0 && tid == 0) {
            float s1 = 0.f, s2 = 0.f;
            for (int i = 0; i < 64; ++i) { s1 += a.in[13][i] * a.in[14][i]; s2 += a.in[15][i] * a.in[16][i]; }
            LAMP[0] = expf(s1) - expf(s2) + 0.2f;
            float gq = 0.f, gk = 0.f;
            for (int i = 0; i < 64; ++i) { gq = fmaxf(gq, fabsf(a.in[11][i])); gk = fmaxf(gk, fabsf(a.in[12][i])); }
            LAMP[1] = 1.02f * 64.f * gq * gk * QSCALE;
        }
    }
    GSYNC(0);

    auto norm_phase = [&](const float* srcX, const float* srcC, int nrows, const float* gain, int sh_chunk, int sc_chunk) {
        const int nchunk = nrows / 8; const int lane = opq(lane_id());
        for (int ch = gw; ch < nchunk; ch += NW) {
            const int r0 = ch * 8; const int mb = r0 < TX ? (r0 >> 12) : 16;
            f32x4 ga[4], sh[4];
#pragma unroll
            for (int j = 0; j < 4; ++j) { const int c = 4 * lane + 256 * j;
                const f32x4 g4 = *(const f32x4*)(gain + c), sc4 = *(const f32x4*)(MOD + (size_t)mb * NMODC + sc_chunk * D + c);
                ga[j] = g4 * (sc4 + 1.0f); sh[j] = *(const f32x4*)(MOD + (size_t)mb * NMODC + sh_chunk * D + c); }
            for (int rr = 0; rr < 8; ++rr) {
                const int r = r0 + rr;
                const float* xr = r < TX ? srcX + (size_t)r * D : srcC + (size_t)(r - TX) * D;
                f32x4 v[4]; float s = 0.f;
#pragma unroll
                for (int j = 0; j < 4; ++j) { v[j] = *(const f32x4*)(xr + 4 * lane + 256 * j); s += (v[j][0] * v[j][0] + v[j][1] * v[j][1]) + (v[j][2] * v[j][2] + v[j][3] * v[j][3]); }
                const float rstd = rsqrtf(wave_sum(s) * (1.f / D) + EPS);
#pragma unroll
                for (int j = 0; j < 4; ++j) { const f32x4 y = v[j] * rstd * ga[j] + sh[j]; u32x2 w; w.x = pk2(y[0], y[1]); w.y = pk2(y[2], y[3]);
                    *(u32x2*)(HBUF + (size_t)r * D + 4 * lane + 256 * j) = w; }
            }
        }
    };

    PH(1) { norm_phase(Xin, Cin, TT, a.in[6], 0, 1); }
    GSYNC(1);
#ifndef REPG
#define REPG 1
#endif
#pragma unroll 1
    for (int rg = 0; rg < REPG; ++rg)
    PH(2) { pg8::SegOrder S; S.init(272, 22, 0, 0, 0, 1, G, cb); pg8::Gemm g{HBUF, W13_1, D}; EpiSwiglu E{ACT}; pg8::gemm_phase<EpiSwiglu, false>(lds, g, S, E, wave); }
    GSYNC(2);
#pragma unroll 1
    for (int rg = 0; rg < REPG; ++rg)
    PH(3) { pg8::SegOrder S; S.init(272, 4, 0, 0, 0, 1, G, cb); pg8::Gemm g{ACT, W2_1, DFF}; EpiResid E{Xin, Cin, X1, MOD + 2 * D, 0.5f}; pg8::gemm_phase<EpiResid, false>(lds, g, S, E, wave); }
    GSYNC(3);
#ifndef REP56
#define REP56 1
#endif
#pragma unroll 1
    for (int rep56 = 0; rep56 < REP56; ++rep56) {
    PH(4) { norm_phase(X1, X1 + (size_t)TX * D, TT, a.in[9], 3, 4); }
    GSYNC(4);
#ifndef REP5
#define REP5 1
#endif
#pragma unroll 1
    for (int r5 = 0; r5 < REP5; ++r5)
    PH(5) {
        { pg8::SegOrder S; S.init(256, 18, 256, 16, 4, 6, G, cb); pg8::Gemm g{HBUF, WINM, D}; EpiInMain E{QB, KB, UG, GA, GS, a.in[11], a.in[12], ROPEC, ROPES}; pg8::gemm_phase<EpiInMain, false>(lds, g, S, E, wave); }
        { pg8::SegOrder S; S.init(272, 4, 0, 0, 0, 1, G, cb); pg8::Gemm g{HBUF, WINV, D}; EpiInV E{VT}; pg8::gemm_phase<EpiInV, true>(lds, g, S, E, wave); }
    }
    GSYNC(5);

    PH(6) {
        const int lane = opq(lane_id()), tid = wave * 64 + lane;
        const int hh = lane >> 5, l31 = lane & 31;
#ifndef REPS
#define REPS 1
#endif
#pragma unroll 1
        for (int rs = 0; rs < REPS; ++rs)
        for (int si = cb; si < 256; si += G) if (wave < 4) {
            const int task = si * 4 + wave, b = task >> 6, d = (task >> 5) & 1, g = task & 31, dg = d * 32 + g;
            LAS unsigned char* wl = lds + wave * 16896;
            const float ar = S5AR[dg * 64 + lane], ai = S5AI[dg * 64 + lane];
            bf16x8 bfr[4], cfr[4];
#pragma unroll
            for (int nt = 0; nt < 4; ++nt) bfr[nt] = *(const bf16x8*)(SBB + ((size_t)dg * 128 + l31 + 32 * nt) * 16 + 8 * hh);
#pragma unroll
            for (int kk = 0; kk < 4; ++kk) cfr[kk] = *(const bf16x8*)(SCM + ((size_t)dg * 16 + (lane & 15)) * 128 + 32 * kk + 8 * (lane >> 4));
            const bf16_t* ug = UG + (size_t)(b * 32 + g) * LK * 16;
            bf16_t* yo = YB + ((size_t)d * TX + (size_t)b * SEQ) * 512 + g * 16;
            float hr = 0.f, hi = 0.f;
            auto upos = [&](int ch) { const int s = 32 * ch + l31; return d == 0 ? s : (s < LC ? LC - 1 - s : LK + LC - 1 - s); };
            bf16x8 afn = *(const bf16x8*)(ug + (size_t)upos(0) * 16 + 8 * hh);
            for (int ch = 0; ch < LK / 32; ++ch) {
                const bf16x8 af = afn;
                if (ch + 1 < LK / 32) afn = *(const bf16x8*)(ug + (size_t)upos(ch + 1) * 16 + 8 * hh);
                f32x16 bu[4];
#pragma unroll
                for (int nt = 0; nt < 4; ++nt) { f32x16 z;
#pragma unroll
                    for (int q = 0; q < 16; ++q) z[q] = 0.f;
                    bu[nt] = __builtin_amdgcn_mfma_f32_32x32x16_bf16(af, bfr[nt], z, 0, 0, 0); }
#pragma unroll
                for (int nt = 0; nt < 4; ++nt)
#pragma unroll
                    for (int r = 0; r < 16; ++r) { const int t = 8 * (r >> 2) + 4 * hh + (r & 3); *(LAS float*)(wl + t * 528 + (l31 + 32 * nt) * 4) = bu[nt][r]; }
                CFENCE();
                float br[32], bi[32];
#pragma unroll
                for (int t = 0; t < 32; ++t) { const f32x2_t v = *(const LAS f32x2_t*)(wl + t * 528 + lane * 8); br[t] = v[0]; bi[t] = v[1]; }
                CFENCE();
#pragma unroll
                for (int t = 0; t < 32; ++t) {
                    const float nhr = fmaf(-ai, hi, fmaf(ar, hr, br[t])), nhi = fmaf(ai, hr, fmaf(ar, hi, bi[t]));
                    hr = nhr; hi = nhi;
                    *(LAS unsigned*)(wl + t * 528 + lane * 4) = pk2(hr, hi);
                }
                CFENCE();
                if (ch >= LC / 32) {
#pragma unroll
                    for (int mt = 0; mt < 2; ++mt) {
                        f32x4 y = (f32x4){0.f, 0.f, 0.f, 0.f};
#pragma unroll
                        for (int kk = 0; kk < 4; ++kk) { const bf16x8 hf = *(const LAS bf16x8*)(wl + (16 * mt + (lane & 15)) * 528 + (32 * kk + 8 * (lane >> 4)) * 2);
                            y = __builtin_amdgcn_mfma_f32_16x16x32_bf16(cfr[kk], hf, y, 0, 0, 0); }
                        const int s2 = 32 * ch + 16 * mt + (lane & 15);
                        const int tok = d == 0 ? s2 - LC : (LK - 1 - s2);
                        u32x2 w; w.x = pk2(y[0], y[1]); w.y = pk2(y[2], y[3]);
                        *(u32x2*)(yo + (size_t)tok * 512 + 4 * (lane >> 4)) = w;
                    }
                }
                CFENCE();
            }
        }
        __syncthreads();
        const float negC = __builtin_amdgcn_readfirstlane(__float_as_int(LAMP[1] > 64.f ? -LAMP[1] : 0.f)) == 0 ? 0.f : -LAMP[1];
#ifndef REPA
#define REPA 1
#endif
#pragma unroll 1
        for (int repa = 0; repa < REPA; ++repa)
        for (int ai_ = cb; ai_ < NB * NH * 16 * DBG_ATT; ai_ += G) {
            const int lane = opq(lane_id()), hh = lane >> 5, l31 = lane & 31;
            const int cp = ai_ & 255, jr = ai_ >> 8;
            const int bh = 16 * jr + 2 * (cp & 7) + ((cp >> 3) >> 4), qt = (cp >> 3) & 15;
            const int b = bh >> 3, h = bh & 7;
            const int comp = wave >> 2, rg = wave & 3;
            const size_t row0 = (size_t)b * SEQ + qt * 256 + rg * 64;
            LAS unsigned char* qb_ = lds + 71680 + wave * 9216;
            {
                u32x4 qr[8];
#pragma unroll
                for (int j = 0; j < 8; ++j) { const int q = 8 * j + (lane >> 3), c = lane & 7; qr[j] = *(const u32x4*)(QB + (row0 + q) * D + h * 128 + comp * 64 + c * 8); }
#pragma unroll
                for (int j = 0; j < 8; ++j) { const int q = 8 * j + (lane >> 3), c = lane & 7; *(LAS u32x4*)(qb_ + q * 144 + c * 16) = qr[j]; }
            }
            f32x16 O[2][4];
#pragma unroll
            for (int qs = 0; qs < 2; ++qs)
#pragma unroll
                for (int mt = 0; mt < 4; ++mt)
#pragma unroll
                    for (int q = 0; q < 16; ++q) O[qs][mt][q] = 0.f;
            float lsum[2] = {0.f, 0.f};
            const bf16_t* Kg = KB + (size_t)bh * LK * 128; const bf16_t* Vg = VT + (size_t)bh * NKT * 8192;
            LAS unsigned* stab = (LAS unsigned*)(lds + 145408 + wave * 1536);
#pragma unroll
            for (int i = 0; i < 3; ++i) { const int slot = 64 * (wave + 8 * i) + lane; int key = slot / 17, c = slot % 17; if (c == 16) c = 0; if (key > 63) key = 63; stab[i * 64 + lane] = (unsigned)(key * 256 + c * 16);
                int dv = slot / 9, c2 = slot % 9; if (c2 == 8) c2 = 0; if (dv > 127) dv = 127; stab[(3 + i) * 64 + lane] = (unsigned)(dv * 128 + c2 * 16); }
            constexpr int KBUF = 17408, VBUF = 18432, VOFF = 2 * KBUF;
#define ATT_STAGE(buf, tile) do { _Pragma("unroll") for (int _i = 0; _i < 3; ++_i) { const int _j = wave + 8 * _i; \
                if (_j < 17) __builtin_amdgcn_global_load_lds((const unsigned*)((const char*)Kg + (size_t)(tile) * 16384 + stab[_i * 64 + lane]), (LAS unsigned*)(lds + (buf) * KBUF + _j * 1024), 16, 0, 0); \
                if (_j < 18) __builtin_amdgcn_global_load_lds((const unsigned*)((const char*)Vg + (size_t)(tile) * 16384 + stab[(3 + _i) * 64 + lane]), (LAS unsigned*)(lds + VOFF + (buf) * VBUF + _j * 1024), 16, 0, 0); } } while (0)
#define SOFTMAX_STEP(S, L, P) do { \
            float ps = 0.f; unsigned pw[8]; \
            if (negC != 0.f) { _Pragma("unroll") for (int q = 0; q < 16; ++q) S[q] += negC; } \
            _Pragma("unroll") for (int q = 0; q < 16; q += 2) { const float e0 = fexp2(S[q]), e1 = fexp2(S[q + 1]); ps += e0 + e1; pw[q >> 1] = pk2(e0, e1); } \
            L += ps; \
            { u32x4 t0 = (u32x4){pw[0], pw[1], pw[2], pw[3]}, t1 = (u32x4){pw[4], pw[5], pw[6], pw[7]}; P[0] = __builtin_bit_cast(bf16x8, t0); P[1] = __builtin_bit_cast(bf16x8, t1); } } while (0)
#define ATT_BAR() do { asm volatile("s_waitcnt lgkmcnt(0)" ::: "memory"); __builtin_amdgcn_s_barrier(); asm volatile("" ::: "memory"); } while (0)
            ATT_STAGE(0, 0);
            asm volatile("s_waitcnt vmcnt(0)" ::: "memory");
            __syncthreads();
            for (int it = 0; it < NKT; ++it) {
                const int cur = it & 1;
                LAS unsigned char* kb_ = lds + cur * KBUF + l31 * 272 + hh * 16 + comp * 128; LAS unsigned char* vb_ = lds + VOFF + cur * VBUF + l31 * 144 + hh * 16;
                LAS unsigned char* qa_ = qb_ + l31 * 144 + hh * 16;
                f32x16 sA0, sA1, sB0, sB1;
#pragma unroll
                for (int q = 0; q < 16; ++q) { sA0[q] = 0.f; sA1[q] = 0.f; sB0[q] = 0.f; sB1[q] = 0.f; }
#pragma unroll
                for (int kk = 0; kk < 4; ++kk) {
                    const bf16x8 kf = *(const LAS bf16x8*)(kb_ + kk * 32);
                    const bf16x8 q0 = *(const LAS bf16x8*)(qa_ + kk * 32), q1 = *(const LAS bf16x8*)(qa_ + 32 * 144 + kk * 32);
                    sA0 = __builtin_amdgcn_mfma_f32_32x32x16_bf16(kf, q0, sA0, 0, 0, 0);
                    sA1 = __builtin_amdgcn_mfma_f32_32x32x16_bf16(kf, q1, sA1, 0, 0, 0);
                }
#pragma unroll
                for (int kk = 0; kk < 4; ++kk) {
                    const bf16x8 kf = *(const LAS bf16x8*)(kb_ + 32 * 272 + kk * 32);
                    const bf16x8 q0 = *(const LAS bf16x8*)(qa_ + kk * 32), q1 = *(const LAS bf16x8*)(qa_ + 32 * 144 + kk * 32);
                    sB0 = __builtin_amdgcn_mfma_f32_32x32x16_bf16(kf, q0, sB0, 0, 0, 0);
                    sB1 = __builtin_amdgcn_mfma_f32_32x32x16_bf16(kf, q1, sB1, 0, 0, 0);
                }
                bf16x8 pA[2][2], pB[2][2];
                SOFTMAX_STEP(sA0, lsum[0], pA[0]);
                SOFTMAX_STEP(sA1, lsum[1], pA[1]);
#pragma unroll
                for (int s = 0; s < 2; ++s) {
                    if (s == 1 && it + 1 < NKT) ATT_STAGE(cur ^ 1, it + 1);
#pragma unroll
                    for (int mt = 0; mt < 4; ++mt) {
                        const bf16x8 vf = *(const LAS bf16x8*)(vb_ + mt * (32 * 144) + (2 * s) * 16);
                        O[0][mt] = __builtin_amdgcn_mfma_f32_32x32x16_bf16(vf, pA[0][s], O[0][mt], 0, 0, 0);
                        O[1][mt] = __builtin_amdgcn_mfma_f32_32x32x16_bf16(vf, pA[1][s], O[1][mt], 0, 0, 0);
                    }
                }
                SOFTMAX_STEP(sB0, lsum[0], pB[0]);
                SOFTMAX_STEP(sB1, lsum[1], pB[1]);
#pragma unroll
                for (int s = 0; s < 2; ++s)
#pragma unroll
                    for (int mt = 0; mt < 4; ++mt) {
                        const bf16x8 vf = *(const LAS bf16x8*)(vb_ + mt * (32 * 144) + (4 + 2 * s) * 16);
                        O[0][mt] = __builtin_amdgcn_mfma_f32_32x32x16_bf16(vf, pB[0][s], O[0][mt], 0, 0, 0);
                        O[1][mt] = __builtin_amdgcn_mfma_f32_32x32x16_bf16(vf, pB[1][s], O[1][mt], 0, 0, 0);
                    }
                asm volatile("s_waitcnt vmcnt(0)" ::: "memory"); ATT_BAR();
            }
            const int lane2 = opq(lane_id()), hh2 = lane2 >> 5, l31b = lane2 & 31;
            lsum[0] += __shfl_xor(lsum[0], 32); lsum[1] += __shfl_xor(lsum[1], 32);
            LAS float* xb = (LAS float*)(lds + rg * 32768) + lane2;
            if (comp == 1) {
                const float lam = LAMP[0];
#pragma unroll
                for (int qs = 0; qs < 2; ++qs) { const float sc = lam * frcp(lsum[qs]);
#pragma unroll
                    for (int mt = 0; mt < 4; ++mt)
#pragma unroll
                        for (int q = 0; q < 16; ++q) xb[((qs * 4 + mt) * 16 + q) * 64] = O[qs][mt][q] * sc; }
            }
            __syncthreads();
            if (comp == 0) {
#pragma unroll
                for (int qs = 0; qs < 2; ++qs) {
                    const float i0 = frcp(lsum[qs]); float ss = 0.f;
#pragma unroll
                    for (int mt = 0; mt < 4; ++mt)
#pragma unroll
                        for (int q = 0; q < 16; ++q) { const float o = O[qs][mt][q] * i0 - xb[((qs * 4 + mt) * 16 + q) * 64]; O[qs][mt][q] = o; ss += o * o; }
                    ss += __shfl_xor(ss, 32);
                    const float rstd = rsqrtf(ss * (1.f / 128.f) + EPS) * 0.8f;
                    bf16_t* op = QB + (row0 + 32 * qs + l31b) * D + h * 128 + 4 * hh2;
#pragma unroll
                    for (int mt = 0; mt < 4; ++mt)
#pragma unroll
                        for (int q4 = 0; q4 < 4; ++q4) {
                            const f32x4 sg = *(const f32x4*)(a.in[17] + 32 * mt + 8 * q4 + 4 * hh2);
                            u32x2 w; w.x = pk2(O[qs][mt][4 * q4] * rstd * sg[0], O[qs][mt][4 * q4 + 1] * rstd * sg[1]); w.y = pk2(O[qs][mt][4 * q4 + 2] * rstd * sg[2], O[qs][mt][4 * q4 + 3] * rstd * sg[3]);
                            *(u32x2*)(op + 32 * mt + 8 * q4) = w;
                        }
                }
            }
            __syncthreads();
        }
    }
    GSYNC(6);
    }

#define BSYNC() do { asm volatile("s_waitcnt vmcnt(0) lgkmcnt(0)" ::: "memory"); __syncthreads(); \
        if (wave == 0) { __builtin_amdgcn_fence(__ATOMIC_ACQUIRE, "agent"); asm volatile("s_waitcnt vmcnt(0) lgkmcnt(0)" ::: "memory"); } __syncthreads(); } while (0)
    PH(7) {
        for (int pm = cb; pm < TX / 256; pm += G) {
            {
                const int tid = wave * 64 + opq(lane_id());
                for (int i = tid; i < 256 * 64; i += 512) {
                    const size_t tok = (size_t)pm * 256 + (i >> 6); const int j = i & 63, ch0 = 8 * j, g = j >> 1, c0 = 8 * (j & 1);
                    const int b = (int)(tok >> 12), t = (int)(tok & (SEQ - 1));
                    const u32x4 y0 = *(const u32x4*)(YB + tok * 512 + ch0), y1 = *(const u32x4*)(YB + ((size_t)TX + tok) * 512 + ch0);
                    const u32x4 uu = *(const u32x4*)(UG + ((size_t)(b * 32 + g) * LK + LC + t) * 16 + c0);
                    const f32x4 d0 = *(const f32x4*)(a.in[25] + ch0), d1 = *(const f32x4*)(a.in[25] + ch0 + 4);
                    u32x4 w;
                    w.x = pk2(gelu_tanh(bflo(y0.x) + bflo(y1.x) + d0[0] * bflo(uu.x)), gelu_tanh(bfhi(y0.x) + bfhi(y1.x) + d0[1] * bfhi(uu.x)));
                    w.y = pk2(gelu_tanh(bflo(y0.y) + bflo(y1.y) + d0[2] * bflo(uu.y)), gelu_tanh(bfhi(y0.y) + bfhi(y1.y) + d0[3] * bfhi(uu.y)));
                    w.z = pk2(gelu_tanh(bflo(y0.z) + bflo(y1.z) + d1[0] * bflo(uu.z)), gelu_tanh(bfhi(y0.z) + bfhi(y1.z) + d1[1] * bfhi(uu.z)));
                    w.w = pk2(gelu_tanh(bflo(y0.w) + bflo(y1.w) + d1[2] * bflo(uu.w)), gelu_tanh(bfhi(y0.w) + bfhi(y1.w) + d1[3] * bfhi(uu.w)));
                    *(u32x4*)(YG + tok * 512 + ch0) = w;
                }
            }
            BSYNC();
            { pg8::SegOrder S; S.init(0, 1, pm, 1, 0, 2, 1, 0); pg8::Gemm g{YG, WGLU, 512}; EpiGlu E{YG, SX, a.in[27]}; pg8::gemm_phase<EpiGlu, false>(lds, g, S, E, wave); }
            BSYNC();
            { pg8::SegOrder S; S.init(0, 1, pm, 1, 0, 4, 1, 0); pg8::Gemm g{SX, WPS, 512}; EpiMerge<false> E{GS, MBUF}; pg8::gemm_phase<EpiMerge<false>, false>(lds, g, S, E, wave); }
            BSYNC();
            { pg8::SegOrder S; S.init(0, 1, pm, 1, 0, 4, 1, 0); pg8::Gemm g{QB, WPA, D}; EpiMerge<true> E{GA, MBUF}; pg8::gemm_phase<EpiMerge<true>, false>(lds, g, S, E, wave); }
            BSYNC();
            { pg8::SegOrder S; S.init(0, 1, pm, 1, 0, 4, 1, 0); pg8::Gemm g{MBUF, WOUT, D}; EpiResid E{X1, X1, X1, MOD + 5 * D, 1.0f}; pg8::gemm_phase<EpiResid, false>(lds, g, S, E, wave); }
            BSYNC();
            {
                const int lane = opq(lane_id()); const int mb = pm >> 4;
                f32x4 ga[4], sh[4];
#pragma unroll
                for (int j = 0; j < 4; ++j) { const int c = 4 * lane + 256 * j;
                    const f32x4 g4 = *(const f32x4*)(a.in[31] + c), sc4 = *(const f32x4*)(MOD + (size_t)mb * NMODC + 7 * D + c);
                    ga[j] = g4 * (sc4 + 1.0f); sh[j] = *(const f32x4*)(MOD + (size_t)mb * NMODC + 6 * D + c); }
                for (int rr = wave; rr < 256; rr += 8) {
                    const size_t r = (size_t)pm * 256 + rr;
                    const float* xr = X1 + r * D;
                    f32x4 v[4]; float s2 = 0.f;
#pragma unroll
                    for (int j = 0; j < 4; ++j) { v[j] = *(const f32x4*)(xr + 4 * lane + 256 * j); s2 += (v[j][0] * v[j][0] + v[j][1] * v[j][1]) + (v[j][2] * v[j][2] + v[j][3] * v[j][3]); }
                    const float rstd = rsqrtf(wave_sum(s2) * (1.f / D) + EPS);
#pragma unroll
                    for (int j = 0; j < 4; ++j) { const f32x4 y = v[j] * rstd * ga[j] + sh[j]; u32x2 w; w.x = pk2(y[0], y[1]); w.y = pk2(y[2], y[3]);
                        *(u32x2*)(GA + r * D + 4 * lane + 256 * j) = w; }
                }
            }
            if (pm + G < TX / 256) BSYNC();
        }
    }
    GSYNC(7);
#pragma unroll 1
    for (int rg = 0; rg < REPG; ++rg)
    PH(13) { pg8::SegOrder S; S.init(256, 22, 0, 0, 0, 1, G, cb); pg8::Gemm g{GA, W13_2, D}; EpiSwiglu E{ACT}; pg8::gemm_phase<EpiSwiglu, false>(lds, g, S, E, wave); }
    GSYNC(13);
    PH(14) { pg8::SegOrder S; S.init(256, 4, 0, 0, 0, 1, G, cb); pg8::Gemm g{ACT, W2_2, DFF}; EpiResid E{X1, X1, a.out, MOD + 8 * D, 0.5f}; pg8::gemm_phase<EpiResid, false>(lds, g, S, E, wave); }
}

extern "C" void kernel_launch(void* const* d_in, const int* in_sizes, int n_in, void* d_out, int out_size, void* d_ws, size_t ws_size, hipStream_t stream) {
    static int grid = 0;
    if (grid == 0) {
        if (n_in != 34 || out_size != TX * D || ws_size < WS_END) { fprintf(stderr, "kernel_launch: unexpected shapes (n_in %d, out %d, ws %zu < %zu)\n", n_in, out_size, ws_size, (size_t)WS_END); grid = -1; return; }
        int dev = 0, cus = 0, per_cu = 0;
        hipGetDevice(&dev); hipDeviceGetAttribute(&cus, hipDeviceAttributeMultiprocessorCount, dev);
        if (hipFuncSetAttribute((const void*)mega, hipFuncAttributeMaxDynamicSharedMemorySize, LDS_BYTES) != hipSuccess) { fprintf(stderr, "kernel_launch: hipFuncSetAttribute failed\n"); grid = -1; return; }
        if (hipOccupancyMaxActiveBlocksPerMultiprocessor(&per_cu, (const void*)mega, 512, LDS_BYTES) != hipSuccess || per_cu < 1) { fprintf(stderr, "kernel_launch: occupancy query says %d\n", per_cu); per_cu = 1; }
        (void)hipGetLastError();
        grid = cus;
    }
    if (grid < 0) return;
    Args a{};
    for (int i = 0; i < 34; ++i) a.in[i] = (const float*)d_in[i];
    a.out = (float*)d_out; a.ws = (unsigned char*)d_ws;
#if MK_SPLIT
    for (int p = 0; p < NPHASE; ++p) { a.ph_lo = p; a.ph_hi = p + 1; hipLaunchKernelGGL(mega, dim3(grid), dim3(512), LDS_BYTES, stream, a); }
#else
    a.ph_lo = 0; a.ph_hi = NPHASE;
    if (hipMemsetAsync((unsigned char*)d_ws + WS_BAR, 0, 256, stream) != hipSuccess) { fprintf(stderr, "kernel_launch: memset of the barrier word failed\n"); return; }
    void* args[] = {&a};
    hipError_t e = hipLaunchCooperativeKernel((const void*)mega, dim3(grid), dim3(512), args, LDS_BYTES, stream);
    if (e != hipSuccess) fprintf(stderr, "cooperative launch failed: %s (grid %d)\n", hipGetErrorString(e), grid);
#endif
}
```

```cpp
#include <hip/hip_runtime.h>
#include <hip/hip_cooperative_groups.h>
#include <cstdio>
#include <cstdint>
namespace cg = cooperative_groups;

#define LAS __attribute__((address_space(3)))
typedef unsigned short bf16_t;
typedef short bf16x8 __attribute__((ext_vector_type(8)));
typedef float f32x4 __attribute__((ext_vector_type(4)));
typedef float f32x16 __attribute__((ext_vector_type(16)));
typedef unsigned u32x4 __attribute__((ext_vector_type(4)));
typedef unsigned u32x2 __attribute__((ext_vector_type(2)));

#define DBG_ATT 1
#define REPG 1
#define REP5 1
#ifndef MK_SPLIT
#define MK_SPLIT 0
#endif

constexpr int D = 1024, NB = 16, SEQ = 4096, LC = 256, LK = SEQ + LC, TX = NB * SEQ, TC = NB * LC, TT = TX + TC;
constexpr int NH = 8, DFF = 2816, NMODC = 9 * D, NKT = LK / 64;
constexpr int NPHASE = 15;
constexpr float EPS = 1e-6f;
constexpr float QSCALE = 0.125f * 1.4426950408889634f;

constexpr size_t al256(size_t x) { return (x + 255) & ~(size_t)255; }
constexpr size_t WS_W13_1 = 0;
constexpr size_t WS_W2_1 = WS_W13_1 + (size_t)2 * DFF * D * 2;
constexpr size_t WS_WIN_M = WS_W2_1 + (size_t)D * DFF * 2;
constexpr size_t WS_WIN_V = WS_WIN_M + (size_t)4608 * D * 2;
constexpr size_t WS_WGLU = WS_WIN_V + (size_t)D * D * 2;
constexpr size_t WS_WPA = WS_WGLU + (size_t)512 * 512 * 2;
constexpr size_t WS_WPS = WS_WPA + (size_t)D * D * 2;
constexpr size_t WS_WOUT = WS_WPS + (size_t)D * 512 * 2;
constexpr size_t WS_W13_2 = WS_WOUT + (size_t)D * D * 2;
constexpr size_t WS_W2_2 = WS_W13_2 + (size_t)2 * DFF * D * 2;
constexpr size_t WS_MOD = WS_W2_2 + (size_t)D * DFF * 2;
constexpr size_t WS_ROPE = al256(WS_MOD + (size_t)17 * NMODC * 4);
constexpr size_t WS_S5A = WS_ROPE + (size_t)2 * SEQ * 32 * 4;
constexpr size_t WS_SBB = WS_S5A + (size_t)2 * 2 * 32 * 64 * 4;
constexpr size_t WS_SCM = WS_SBB + (size_t)2 * 32 * 128 * 16 * 2;
constexpr size_t WS_LAM = WS_SCM + (size_t)2 * 32 * 16 * 128 * 2;
constexpr size_t WS_BAR = WS_LAM + 256;
constexpr size_t WS_X1 = al256(WS_BAR + 256);
constexpr size_t WS_HBUF = WS_X1 + (size_t)TT * D * 4;
constexpr size_t WS_ACT = WS_HBUF + (size_t)TT * D * 2;
constexpr size_t WS_VT = WS_ACT + (size_t)TT * DFF * 2;
constexpr size_t WS_END = WS_VT + (size_t)NB * NH * LK * 128 * 2;
constexpr size_t WS_Y = WS_HBUF;
constexpr size_t WS_QB = WS_ACT;
constexpr size_t WS_KB = WS_QB + (size_t)TX * D * 2;
constexpr size_t WS_UG = WS_KB + (size_t)NB * NH * LK * 128 * 2;
constexpr size_t WS_YG = WS_KB;
constexpr size_t WS_SX = WS_KB + (size_t)TX * 512 * 2;
constexpr size_t WS_MBUF = WS_VT;
static_assert(WS_UG + (size_t)NB * 32 * LK * 16 * 2 <= WS_VT, "overlay overflow");
static_assert(WS_SX + (size_t)TX * 512 * 2 <= WS_UG, "overlay overflow");

constexpr int LDS_BYTES = 157696;

struct Args { const float* in[34]; float* out; unsigned char* ws; int ph_lo, ph_hi; };

typedef __bf16 bf16x2_t __attribute__((ext_vector_type(2)));
typedef float f32x2_t __attribute__((ext_vector_type(2)));
__device__ __forceinline__ unsigned pk2(float lo, float hi) { f32x2_t v = {lo, hi}; bf16x2_t r = __builtin_convertvector(v, bf16x2_t); return __builtin_bit_cast(unsigned, r); }
__device__ __forceinline__ float bf2f(unsigned short b) { return __uint_as_float(((unsigned)b) << 16); }
__device__ __forceinline__ float bflo(unsigned w) { return __uint_as_float(w << 16); }
__device__ __forceinline__ float bfhi(unsigned w) { return __uint_as_float(w & 0xffff0000u); }
__device__ __forceinline__ float fexp2(float x) { return __builtin_amdgcn_exp2f(x); }
__device__ __forceinline__ float frcp(float x) { return __builtin_amdgcn_rcpf(x); }
__device__ __forceinline__ float sigmoidf_(float x) { return frcp(1.f + fexp2(-1.4426950408889634f * x)); }
__device__ __forceinline__ float siluf_(float x) { return x * sigmoidf_(x); }
__device__ __forceinline__ float gelu_tanh(float x) { const float u = 0.7978845608028654f * (x + 0.044715f * x * x * x); return x * sigmoidf_(2.f * u); }
__device__ __forceinline__ float wave_sum(float v) {
#pragma unroll
    for (int o = 1; o < 64; o <<= 1) v += __shfl_xor(v, o);
    return v;
}
__device__ __forceinline__ int opq(int x) { asm volatile("" : "+v"(x)); return x; }
__device__ __forceinline__ int lane_id() { return (int)__builtin_amdgcn_mbcnt_hi(~0u, __builtin_amdgcn_mbcnt_lo(~0u, 0u)); }
#define LDS_WAIT() asm volatile("s_waitcnt lgkmcnt(0)" ::: "memory")
#define CFENCE() asm volatile("" ::: "memory")

namespace pg8 {
constexpr int BM = 256, BK = 64, HALF = 128, HTB = HALF * BK * 2, STAGE_BYTES = 8 * HTB, NXCD = 8, WGM = 8;
__host__ __device__ __forceinline__ int lds_byte(int r, int c) { const int st = (r >> 4) * 2 + (c >> 5), rr = r & 15, cc = c & 31, ob = rr * 64 + cc * 2; return st * 1024 + (ob ^ (((ob >> 9) & 1) << 5)); }
__host__ __device__ __forceinline__ void stage_rc(int b, int& R, int& C) { const int st = b / 1024, sb = b % 1024, swz = sb ^ (((sb >> 9) & 1) << 5); R = (st >> 1) * 16 + swz / 64; C = (st & 1) * 32 + (swz % 64) / 2; }
__host__ __device__ __forceinline__ int perm32(int rho) { const int n = rho >> 4, i = rho & 15; return 8 * (i >> 2) + 4 * n + (i & 3); }
struct Unit { int pm, pn; };
struct Gemm { const bf16_t* A; const bf16_t* Bt; int K; };

struct SegOrder {
    int nM1, nN1, n1, pm2, nM2, pn2, nN2, n2, G, c;
    __device__ __forceinline__ void init(int nM1_, int nN1_, int pm2_, int nM2_, int pn2_, int nN2_, int G_, int c_) {
        nM1 = nM1_; nN1 = nN1_; n1 = nM1 * nN1; pm2 = pm2_; nM2 = nM2_; pn2 = pn2_; nN2 = nN2_; n2 = nM2 * nN2; G = G_; c = c_; }
    __device__ __forceinline__ bool next(int i, Unit& u) const {
        long L = (long)i * G + c;
        if (L < n1) {
            int wgid = (int)L; { const int q = n1 / NXCD, r = n1 % NXCD, xcd = wgid % NXCD, off = wgid / NXCD; wgid = (xcd < r ? xcd * (q + 1) : r * (q + 1) + (xcd - r) * q) + off; }
            const int nig = WGM * nN1, gid = wgid / nig, fm = gid * WGM, gsz = (nM1 - fm) < WGM ? (nM1 - fm) : WGM;
            u.pm = fm + ((wgid % nig) % gsz); u.pn = (wgid % nig) / gsz; return true;
        }
        L -= n1; if (L >= n2) return false;
        u.pm = pm2 + (int)(L / nN2); u.pn = pn2 + (int)(L % nN2); return true;
    }
};

template <class Epi, bool SWAP>
__device__ __forceinline__ void gemm_phase(LAS unsigned char* lds, const Gemm g, const SegOrder& S, const Epi& E, int wid) {
    const int lane = opq(lane_id()), tid = wid * 64 + lane, wr = wid >> 2, wc = wid & 3, fr = lane & 15, fq = lane >> 4;
    const int K = g.K, nt = K / BK;
    unsigned voffA[2], voffB[2];
#pragma unroll
    for (int i = 0; i < 2; ++i) { int R, C; stage_rc(tid * 16 + i * 8192, R, C); const int Rb = Epi::PERM ? ((R & ~31) + perm32(R & 31)) : R;
        voffA[i] = (unsigned)(R * K + C) * 2u; voffB[i] = (unsigned)(Rb * K + C) * 2u; }
    const size_t kstep = (size_t)(BK * 2);
    const size_t hstep = (size_t)HALF * K * 2;
    const size_t tstep = 2 * hstep;
    const unsigned ldsw = (unsigned)wid * 1024u;
    const int aoff = lds_byte(wr * 64 + fr, fq * 8), boff = lds_byte(wc * 32 + fr, fq * 8);
#define PG8_SA(b, h) (((b) * 2 + (h)) * HTB)
#define PG8_SB(b, h) ((4 + (b) * 2 + (h)) * HTB)
#define PG8_STAGE(bufoff, gbase, voff) do { _Pragma("unroll") for (int _i = 0; _i < 2; ++_i) \
        __builtin_amdgcn_global_load_lds((const unsigned*)((const char*)(gbase) + (voff)[_i]), (LAS unsigned*)(lds + (bufoff) + ldsw + _i * 8192), 16, 0, 0); } while (0)
#define PG8_LDA(dst, b, h) do { _Pragma("unroll") for (int m = 0; m < 4; ++m) _Pragma("unroll") for (int k = 0; k < 2; ++k) dst[m][k] = *(const LAS bf16x8*)(lds + PG8_SA(b, h) + aoff + m * 2048 + k * 1024); } while (0)
#define PG8_LDB(dst, b, h) do { _Pragma("unroll") for (int n = 0; n < 2; ++n) _Pragma("unroll") for (int k = 0; k < 2; ++k) dst[n][k] = *(const LAS bf16x8*)(lds + PG8_SB(b, h) + boff + n * 2048 + k * 1024); } while (0)
#define PG8_MMA(ai, bj, At, Bt) do { __builtin_amdgcn_s_setprio(1); _Pragma("unroll") for (int m = 0; m < 4; ++m) _Pragma("unroll") for (int n = 0; n < 2; ++n) _Pragma("unroll") for (int k = 0; k < 2; ++k) \
        acc[ai][bj][m][n] = SWAP ? __builtin_amdgcn_mfma_f32_16x16x32_bf16(At[m][k], Bt[n][k], acc[ai][bj][m][n], 0, 0, 0) \
                                 : __builtin_amdgcn_mfma_f32_16x16x32_bf16(Bt[n][k], At[m][k], acc[ai][bj][m][n], 0, 0, 0); __builtin_amdgcn_s_setprio(0); } while (0)
#define PG8_WAIT_V(n) asm volatile("s_waitcnt vmcnt(" #n ")" ::: "memory")
#define PG8_WAIT_L(n) asm volatile("s_waitcnt lgkmcnt(" #n ")" ::: "memory")
#define PG8_BAR __builtin_amdgcn_s_barrier()
#define PG8_SCHED __builtin_amdgcn_sched_barrier(0)
    Unit cur, nxt; int ui = 0;
    if (!S.next(0, cur)) return;
    f32x4 acc[2][2][4][2];
#pragma unroll
    for (int a = 0; a < 2; ++a)
#pragma unroll
        for (int b = 0; b < 2; ++b)
#pragma unroll
            for (int m = 0; m < 4; ++m)
#pragma unroll
                for (int n = 0; n < 2; ++n) acc[a][b][m][n] = (f32x4){0.f, 0.f, 0.f, 0.f};
    bf16x8 At[4][2], B0[2][2], B1[2][2];
    const char* cA = (const char*)g.A + (size_t)cur.pm * tstep; const char* cB = (const char*)g.Bt + (size_t)cur.pn * tstep;
    PG8_STAGE(PG8_SB(0, 0), cB, voffB); PG8_STAGE(PG8_SB(0, 1), cB + hstep, voffB); PG8_STAGE(PG8_SA(0, 0), cA, voffA); PG8_STAGE(PG8_SA(0, 1), cA + hstep, voffA);
    if (wr == 1) PG8_BAR;
    PG8_WAIT_V(2); PG8_BAR;
    PG8_STAGE(PG8_SB(1, 0), cB + kstep, voffB); PG8_STAGE(PG8_SA(1, 0), cA + kstep, voffA); PG8_STAGE(PG8_SB(1, 1), cB + hstep + kstep, voffB);
    PG8_WAIT_V(6); PG8_BAR;
    for (;;) {
        const bool has_next = S.next(ui + 1, nxt);
        const char* nA = has_next ? (const char*)g.A + (size_t)nxt.pm * tstep : cA; const char* nB = has_next ? (const char*)g.Bt + (size_t)nxt.pn * tstep : cB;
        for (int t = 0; t < nt; t += 2) {
            const bool last = (t == nt - 2);
            const char* a1 = cA + (size_t)(t + 1) * kstep;
            const char* a2 = last ? nA : cA + (size_t)(t + 2) * kstep; const char* b2 = last ? nB : cB + (size_t)(t + 2) * kstep;
            const char* a3 = a2 + kstep; const char* b3 = b2 + kstep;
            PG8_LDB(B0, 0, 0); PG8_LDB(B1, 0, 1); PG8_SCHED; PG8_LDA(At, 0, 0); PG8_STAGE(PG8_SA(1, 1), a1 + hstep, voffA);
            PG8_WAIT_V(8); PG8_WAIT_L(0); PG8_BAR; PG8_MMA(0, 0, At, B0); PG8_MMA(0, 1, At, B1); PG8_BAR; PG8_SCHED;
            PG8_LDA(At, 0, 1); PG8_STAGE(PG8_SB(0, 0), b2, voffB); PG8_STAGE(PG8_SB(0, 1), b2 + hstep, voffB); PG8_STAGE(PG8_SA(0, 0), a2, voffA);
            PG8_WAIT_V(8); PG8_WAIT_L(0); PG8_BAR; PG8_MMA(1, 0, At, B0); PG8_MMA(1, 1, At, B1); PG8_BAR; PG8_SCHED;
            PG8_LDB(B0, 1, 0); PG8_LDB(B1, 1, 1); PG8_SCHED; PG8_LDA(At, 1, 0); PG8_STAGE(PG8_SA(0, 1), a2 + hstep, voffA);
            PG8_WAIT_V(8); PG8_WAIT_L(0); PG8_BAR; PG8_MMA(0, 0, At, B0); PG8_MMA(0, 1, At, B1); PG8_BAR; PG8_SCHED;
            PG8_LDA(At, 1, 1); PG8_STAGE(PG8_SB(1, 0), b3, voffB); PG8_STAGE(PG8_SB(1, 1), b3 + hstep, voffB); PG8_STAGE(PG8_SA(1, 0), a3, voffA);
            PG8_WAIT_V(8); PG8_WAIT_L(0); PG8_BAR; PG8_MMA(1, 0, At, B0); PG8_MMA(1, 1, At, B1); PG8_BAR; PG8_SCHED;
        }
        if (wr == 0) PG8_BAR;
        E(acc, cur, wr, wc, fr, fq);
        if (!has_next) break;
#pragma unroll
        for (int a = 0; a < 2; ++a)
#pragma unroll
            for (int b = 0; b < 2; ++b)
#pragma unroll
                for (int m = 0; m < 4; ++m)
#pragma unroll
                    for (int n = 0; n < 2; ++n) acc[a][b][m][n] = (f32x4){0.f, 0.f, 0.f, 0.f};
        cur = nxt; cA = nA; cB = nB; ++ui;
        if (wr == 1) PG8_BAR;
    }
    PG8_WAIT_V(0);
    PG8_BAR;
#undef PG8_SA
#undef PG8_SB
#undef PG8_STAGE
#undef PG8_LDA
#undef PG8_LDB
#undef PG8_MMA
#undef PG8_WAIT_V
#undef PG8_WAIT_L
#undef PG8_BAR
#undef PG8_SCHED
}
}
using pg8::Unit;


struct EpiSwiglu {
    static constexpr bool PERM = true;
    bf16_t* O;
    __device__ __forceinline__ void operator()(const f32x4 (&acc)[2][2][4][2], const Unit& u, int wr, int wc, int fr, int fq) const {
        const int row0 = u.pm * 256 + wr * 64 + fr, col0 = u.pn * 128 + wc * 32 + 8 * fq;
#pragma unroll
        for (int ai = 0; ai < 2; ++ai)
#pragma unroll
            for (int m = 0; m < 4; ++m) {
                const f32x4 a0 = acc[ai][0][m][0], a1 = acc[ai][0][m][1], b0 = acc[ai][1][m][0], b1 = acc[ai][1][m][1];
                u32x4 w;
                w.x = pk2(siluf_(a0[0]) * b0[0], siluf_(a0[1]) * b0[1]); w.y = pk2(siluf_(a0[2]) * b0[2], siluf_(a0[3]) * b0[3]);
                w.z = pk2(siluf_(a1[0]) * b1[0], siluf_(a1[1]) * b1[1]); w.w = pk2(siluf_(a1[2]) * b1[2], siluf_(a1[3]) * b1[3]);
                *(u32x4*)(O + (size_t)(row0 + ai * 128 + m * 16) * DFF + col0) = w;
            }
    }
};

struct EpiResid {
    static constexpr bool PERM = false;
    const float* srcX; const float* srcC; float* dst; const float* gate; float coef;
    __device__ __forceinline__ void operator()(const f32x4 (&acc)[2][2][4][2], const Unit& u, int wr, int wc, int fr, int fq) const {
        const int mb = u.pm < 256 ? (u.pm >> 4) : 16;
        const float* sp = u.pm < 256 ? srcX + (size_t)u.pm * 256 * D : srcC + (size_t)(u.pm - 256) * 256 * D;
        float* dp = dst + (size_t)u.pm * 256 * D;
        const int rl = wr * 64 + fr, col0 = u.pn * 256 + wc * 32 + 4 * fq;
        f32x4 gv[2][2];
#pragma unroll
        for (int bj = 0; bj < 2; ++bj)
#pragma unroll
            for (int n = 0; n < 2; ++n) gv[bj][n] = *(const f32x4*)(gate + (size_t)mb * NMODC + col0 + bj * 128 + n * 16) * coef;
#pragma unroll
        for (int ai = 0; ai < 2; ++ai)
#pragma unroll
            for (int m = 0; m < 4; ++m) {
                const size_t ro = (size_t)(rl + ai * 128 + m * 16) * D + col0;
#pragma unroll
                for (int bj = 0; bj < 2; ++bj)
#pragma unroll
                    for (int n = 0; n < 2; ++n) { const f32x4 s = *(const f32x4*)(sp + ro + bj * 128 + n * 16); *(f32x4*)(dp + ro + bj * 128 + n * 16) = s + gv[bj][n] * acc[ai][bj][m][n]; }
            }
    }
};

struct EpiInMain {
    static constexpr bool PERM = true;
    bf16_t* QB; bf16_t* KB; bf16_t* UG; bf16_t* GA; bf16_t* GS; const float* qn; const float* kn; const float* ropec; const float* ropes;
    __device__ __forceinline__ void operator()(const f32x4 (&acc)[2][2][4][2], const Unit& u, int wr, int wc, int fr, int fq) const {
        const int pn = u.pn; const bool isx = u.pm < 256;
        const int rl = wr * 64 + fr;
        if (pn < 8) {
            const bool isq = pn < 4;
            const float* gn = isq ? qn : kn;
            f32x4 g[2][2];
#pragma unroll
            for (int bj = 0; bj < 2; ++bj)
#pragma unroll
                for (int n = 0; n < 2; ++n) g[bj][n] = *(const f32x4*)(gn + 32 * bj + 8 * fq + 4 * n);
            const int hcg = 4 * (pn & 3) + wc, head = hcg >> 1, comp = hcg & 1;
#pragma unroll
            for (int ai = 0; ai < 2; ++ai)
#pragma unroll
                for (int m = 0; m < 4; ++m) {
                    const int r = u.pm * 256 + rl + ai * 128 + m * 16;
                    f32x4 v[2][2]; float ss = 0.f;
#pragma unroll
                    for (int bj = 0; bj < 2; ++bj)
#pragma unroll
                        for (int n = 0; n < 2; ++n) { v[bj][n] = acc[ai][bj][m][n]; ss += (v[bj][n][0] * v[bj][n][0] + v[bj][n][1] * v[bj][n][1]) + (v[bj][n][2] * v[bj][n][2] + v[bj][n][3] * v[bj][n][3]); }
                    ss += __shfl_xor(ss, 16); ss += __shfl_xor(ss, 32);
                    const float rstd = rsqrtf(ss * (1.f / 64.f) + EPS);
#pragma unroll
                    for (int bj = 0; bj < 2; ++bj)
#pragma unroll
                        for (int n = 0; n < 2; ++n) v[bj][n] = v[bj][n] * rstd * g[bj][n];
                    if (isx) {
                        const int t = r & (SEQ - 1);
#pragma unroll
                        for (int n = 0; n < 2; ++n) {
                            const f32x4 cs = *(const f32x4*)(ropec + t * 32 + 8 * fq + 4 * n), sn = *(const f32x4*)(ropes + t * 32 + 8 * fq + 4 * n);
                            const f32x4 t1 = v[0][n], t2 = v[1][n];
                            v[0][n] = t1 * cs - t2 * sn; v[1][n] = t2 * cs + t1 * sn;
                        }
                    }
                    bf16_t* dstp;
                    if (isq) {
#pragma unroll
                        for (int bj = 0; bj < 2; ++bj)
#pragma unroll
                            for (int n = 0; n < 2; ++n) v[bj][n] = v[bj][n] * QSCALE;
                        dstp = QB + (size_t)r * D + hcg * 64 + 8 * fq;
                    } else {
                        int b, pos; if (isx) { b = r >> 12; pos = LC + (r & (SEQ - 1)); } else { const int rc = r - TX; b = rc >> 8; pos = rc & (LC - 1); }
                        dstp = KB + (((size_t)(b * NH + head) * LK + pos) * 2 + comp) * 64 + 8 * fq;
                    }
#pragma unroll
                    for (int bj = 0; bj < 2; ++bj) {
                        u32x4 w; w.x = pk2(v[bj][0][0], v[bj][0][1]); w.y = pk2(v[bj][0][2], v[bj][0][3]); w.z = pk2(v[bj][1][0], v[bj][1][1]); w.w = pk2(v[bj][1][2], v[bj][1][3]);
                        *(u32x4*)(dstp + 32 * bj) = w;
                    }
                }
        } else if (pn < 10) {
#pragma unroll
            for (int ai = 0; ai < 2; ++ai)
#pragma unroll
                for (int m = 0; m < 4; ++m) {
                    const int r = u.pm * 256 + rl + ai * 128 + m * 16;
                    int b, pos; if (isx) { b = r >> 12; pos = LC + (r & (SEQ - 1)); } else { const int rc = r - TX; b = rc >> 8; pos = rc & (LC - 1); }
#pragma unroll
                    for (int bj = 0; bj < 2; ++bj) {
                        const int ch0 = 256 * (pn - 8) + 128 * bj + 32 * wc + 8 * fq, gidx = ch0 >> 4, c0 = ch0 & 15;
                        const f32x4 v0 = acc[ai][bj][m][0], v1 = acc[ai][bj][m][1];
                        u32x4 w; w.x = pk2(v0[0], v0[1]); w.y = pk2(v0[2], v0[3]); w.z = pk2(v1[0], v1[1]); w.w = pk2(v1[2], v1[3]);
                        *(u32x4*)(UG + ((size_t)(b * 32 + gidx) * LK + pos) * 16 + c0) = w;
                    }
                }
        } else {
            bf16_t* Gd = pn < 14 ? GA : GS; const int pq = pn < 14 ? pn - 10 : pn - 14;
#pragma unroll
            for (int ai = 0; ai < 2; ++ai)
#pragma unroll
                for (int m = 0; m < 4; ++m) {
                    const int r = u.pm * 256 + rl + ai * 128 + m * 16;
#pragma unroll
                    for (int bj = 0; bj < 2; ++bj) {
                        const f32x4 v0 = acc[ai][bj][m][0], v1 = acc[ai][bj][m][1];
                        u32x4 w; w.x = pk2(sigmoidf_(v0[0]), sigmoidf_(v0[1])); w.y = pk2(sigmoidf_(v0[2]), sigmoidf_(v0[3])); w.z = pk2(sigmoidf_(v1[0]), sigmoidf_(v1[1])); w.w = pk2(sigmoidf_(v1[2]), sigmoidf_(v1[3]));
                        *(u32x4*)(Gd + (size_t)r * D + 256 * pq + 128 * bj + 32 * wc + 8 * fq) = w;
                    }
                }
        }
    }
};

struct EpiInV {
    static constexpr bool PERM = false;
    bf16_t* VT;
    __device__ __forceinline__ void operator()(const f32x4 (&acc)[2][2][4][2], const Unit& u, int wr, int wc, int fr, int fq) const {
        const bool isx = u.pm < 256;
#pragma unroll
        for (int ai = 0; ai < 2; ++ai)
#pragma unroll
            for (int m = 0; m < 4; ++m) {
                const int r = u.pm * 256 + ai * 128 + wr * 64 + m * 16 + 4 * fq;
                int b, pos; if (isx) { b = r >> 12; pos = LC + (r & (SEQ - 1)); } else { const int rc = r - TX; b = rc >> 8; pos = rc & (LC - 1); }
                const int tile = pos >> 6, kp = pos & 63, k16 = kp & 15, sp = (kp & 48) + 8 * ((k16 >> 2) & 1) + 4 * (k16 >> 3);
#pragma unroll
                for (int bj = 0; bj < 2; ++bj)
#pragma unroll
                    for (int n = 0; n < 2; ++n) {
                        const int col = u.pn * 256 + bj * 128 + wc * 32 + n * 16 + fr, h = col >> 7, dv = col & 127;
                        const f32x4 v = acc[ai][bj][m][n];
                        u32x2 w; w.x = pk2(v[0], v[1]); w.y = pk2(v[2], v[3]);
                        *(u32x2*)(VT + (((size_t)(b * NH + h) * NKT + tile) * 128 + dv) * 64 + sp) = w;
                    }
            }
    }
};

struct EpiGlu {
    static constexpr bool PERM = true;
    const bf16_t* YG; bf16_t* SX; const float* bglu;
    __device__ __forceinline__ void operator()(const f32x4 (&acc)[2][2][4][2], const Unit& u, int wr, int wc, int fr, int fq) const {
        const int row0 = u.pm * 256 + wr * 64 + fr, col0 = u.pn * 256 + wc * 32 + 8 * fq;
#pragma unroll
        for (int bj = 0; bj < 2; ++bj) {
            const f32x4 bv0 = *(const f32x4*)(bglu + col0 + bj * 128), bv1 = *(const f32x4*)(bglu + col0 + bj * 128 + 4);
#pragma unroll
            for (int ai = 0; ai < 2; ++ai)
#pragma unroll
                for (int m = 0; m < 4; ++m) {
                    const size_t o = (size_t)(row0 + ai * 128 + m * 16) * 512 + col0 + bj * 128;
                    const u32x4 y = *(const u32x4*)(YG + o);
                    const f32x4 v0 = acc[ai][bj][m][0] + bv0, v1 = acc[ai][bj][m][1] + bv1;
                    u32x4 w;
                    w.x = pk2(bflo(y.x) * sigmoidf_(v0[0]), bfhi(y.x) * sigmoidf_(v0[1])); w.y = pk2(bflo(y.y) * sigmoidf_(v0[2]), bfhi(y.y) * sigmoidf_(v0[3]));
                    w.z = pk2(bflo(y.z) * sigmoidf_(v1[0]), bfhi(y.z) * sigmoidf_(v1[1])); w.w = pk2(bflo(y.w) * sigmoidf_(v1[2]), bfhi(y.w) * sigmoidf_(v1[3]));
                    *(u32x4*)(SX + o) = w;
                }
        }
    }
};

template <bool ACCUM> struct EpiMerge {
    static constexpr bool PERM = true;
    const bf16_t* Gt; bf16_t* Mb;
    __device__ __forceinline__ void operator()(const f32x4 (&acc)[2][2][4][2], const Unit& u, int wr, int wc, int fr, int fq) const {
        const int row0 = u.pm * 256 + wr * 64 + fr, col0 = u.pn * 256 + wc * 32 + 8 * fq;
#pragma unroll
        for (int ai = 0; ai < 2; ++ai)
#pragma unroll
            for (int m = 0; m < 4; ++m)
#pragma unroll
                for (int bj = 0; bj < 2; ++bj) {
                    const size_t o = (size_t)(row0 + ai * 128 + m * 16) * D + col0 + bj * 128;
                    const u32x4 gt = *(const u32x4*)(Gt + o);
                    const f32x4 v0 = acc[ai][bj][m][0], v1 = acc[ai][bj][m][1];
                    float r0 = bflo(gt.x) * v0[0], r1 = bfhi(gt.x) * v0[1], r2 = bflo(gt.y) * v0[2], r3 = bfhi(gt.y) * v0[3];
                    float r4 = bflo(gt.z) * v1[0], r5 = bfhi(gt.z) * v1[1], r6 = bflo(gt.w) * v1[2], r7 = bfhi(gt.w) * v1[3];
                    if (ACCUM) { const u32x4 p = *(const u32x4*)(Mb + o);
                        r0 += bflo(p.x); r1 += bfhi(p.x); r2 += bflo(p.y); r3 += bfhi(p.y); r4 += bflo(p.z); r5 += bfhi(p.z); r6 += bflo(p.w); r7 += bfhi(p.w); }
                    u32x4 w; w.x = pk2(r0, r1); w.y = pk2(r2, r3); w.z = pk2(r4, r5); w.w = pk2(r6, r7);
                    *(u32x4*)(Mb + o) = w;
                }
    }
};

__device__ __forceinline__ void tr_item(const float* W, int K, int N, int k0, int scol0, bf16_t* WT, int drow0, LAS float* scr, int lane) {
#pragma unroll 8
    for (int i = 0; i < 32; ++i) { const int kk = 2 * i + (lane >> 5); scr[kk * 33 + (lane & 31)] = W[(size_t)(k0 + kk) * N + scol0 + (lane & 31)]; }
    LDS_WAIT();
    const int c = lane & 7;
#pragma unroll
    for (int j = 0; j < 4; ++j) { const int n = (lane >> 3) + 8 * j; const LAS float* s = scr + (8 * c) * 33 + n;
        u32x4 o; o.x = pk2(s[0 * 33], s[1 * 33]); o.y = pk2(s[2 * 33], s[3 * 33]); o.z = pk2(s[4 * 33], s[5 * 33]); o.w = pk2(s[6 * 33], s[7 * 33]);
        *(u32x4*)(WT + (size_t)(drow0 + n) * K + k0 + 8 * c) = o; }
    LDS_WAIT();
}
__device__ __forceinline__ int src_w13(int n0) { const int pn = n0 >> 8, s = n0 & 255; return (s >> 7) * DFF + 128 * pn + (s & 127); }
__device__ __forceinline__ int src_winm(int n0) {
    if (n0 < 2048) { const int base = n0 < 1024 ? 0 : 1024, nn = n0 - base, pn = nn >> 8, s = nn & 255, bj = s >> 7, wc = (s & 127) >> 5, hcg = 4 * pn + wc; return base + hcg * 64 + 32 * bj; }
    if (n0 < 2560) return 3072 + (n0 - 2048);
    return 3584 + (n0 - 2560);
}

__global__ void __launch_bounds__(512, 2) mega(Args a) {
    extern __shared__ __attribute__((aligned(16))) unsigned char smem[];
    LAS unsigned char* lds = (LAS unsigned char*)smem;
    const int wave = __builtin_amdgcn_readfirstlane(threadIdx.x >> 6);
    const int G = gridDim.x, cb = blockIdx.x;
    const int gw = cb * 8 + wave, NW = G * 8;
    unsigned char* ws = a.ws;
    bf16_t* W13_1 = (bf16_t*)(ws + WS_W13_1); bf16_t* W2_1 = (bf16_t*)(ws + WS_W2_1); bf16_t* WINM = (bf16_t*)(ws + WS_WIN_M); bf16_t* WINV = (bf16_t*)(ws + WS_WIN_V);
    bf16_t* WGLU = (bf16_t*)(ws + WS_WGLU); bf16_t* WPA = (bf16_t*)(ws + WS_WPA); bf16_t* WPS = (bf16_t*)(ws + WS_WPS); bf16_t* WOUT = (bf16_t*)(ws + WS_WOUT);
    bf16_t* W13_2 = (bf16_t*)(ws + WS_W13_2); bf16_t* W2_2 = (bf16_t*)(ws + WS_W2_2);
    float* MOD = (float*)(ws + WS_MOD); float* ROPEC = (float*)(ws + WS_ROPE); float* ROPES = ROPEC + SEQ * 32;
    float* S5AR = (float*)(ws + WS_S5A); float* S5AI = S5AR + 2 * 32 * 64; bf16_t* SBB = (bf16_t*)(ws + WS_SBB); bf16_t* SCM = (bf16_t*)(ws + WS_SCM); float* LAMP = (float*)(ws + WS_LAM);
    float* X1 = (float*)(ws + WS_X1); bf16_t* HBUF = (bf16_t*)(ws + WS_HBUF); bf16_t* ACT = (bf16_t*)(ws + WS_ACT); bf16_t* VT = (bf16_t*)(ws + WS_VT);
    bf16_t* YB = (bf16_t*)(ws + WS_Y); bf16_t* QB = (bf16_t*)(ws + WS_QB); bf16_t* KB = (bf16_t*)(ws + WS_KB); bf16_t* UG = (bf16_t*)(ws + WS_UG);
    bf16_t* YG = (bf16_t*)(ws + WS_YG); bf16_t* SX = (bf16_t*)(ws + WS_SX); bf16_t* MBUF = (bf16_t*)(ws + WS_MBUF);
    bf16_t* GA = (bf16_t*)a.out; bf16_t* GS = GA + (size_t)TX * D;
    const float* Xin = a.in[0]; const float* Cin = a.in[2];

#ifndef PHMASK
#define PHMASK 0x7fff
#endif
#define PH(n) if (((PHMASK >> (n)) & 1) && a.ph_lo <= (n) && (n) < a.ph_hi)
#if MK_SPLIT
#define GSYNC(n) do { } while (0)
#else
#define GSYNC(n) do { if (a.ph_lo <= (n) && (n) + 1 < a.ph_hi) { bar_t += (unsigned)G; \
        asm volatile("s_waitcnt vmcnt(0) lgkmcnt(0)" ::: "memory");       \
        __syncthreads(); \
        if (wave == 0) {                                                   \
            __builtin_amdgcn_fence(__ATOMIC_RELEASE, "agent"); asm volatile("s_waitcnt vmcnt(0)" ::: "memory"); \
            if (lane_id() == 0) { __hip_atomic_fetch_add(BARW, 1u, __ATOMIC_RELAXED, __HIP_MEMORY_SCOPE_AGENT); \
                while (__hip_atomic_load(BARW, __ATOMIC_RELAXED, __HIP_MEMORY_SCOPE_AGENT) < bar_t) __builtin_amdgcn_s_sleep(1); } \
            __builtin_amdgcn_fence(__ATOMIC_ACQUIRE, "agent"); asm volatile("s_waitcnt vmcnt(0) lgkmcnt(0)" ::: "memory"); } \
        __syncthreads(); } } while (0)
#endif
    unsigned* BARW = (unsigned*)(ws + WS_BAR); unsigned bar_t = 0;
#if !MK_SPLIT
    if (a.ph_lo == 0) cg::this_grid().sync();
#endif

    PH(0) {
        const int lane = opq(lane_id()), tid = wave * 64 + lane;
        for (int slab = cb; slab < NMODC / 64; slab += G) {
            LAS float* sl = (LAS float*)lds;
            LAS float* red = (LAS float*)(lds + 17 * 1024 * 4);
            for (int i = tid; i < 17 * 1024; i += 512) { const int mb = i >> 10, k = i & 1023; const float v = mb < 16 ? a.in[1][mb * 1024 + k] : a.in[3][k]; sl[i] = siluf_(v); }
            __syncthreads();
            float accm[17];
#pragma unroll
            for (int j = 0; j < 17; ++j) accm[j] = 0.f;
            const float* wp = a.in[4] + (size_t)(wave * 128) * NMODC + slab * 64 + lane;
#pragma unroll 4
            for (int k = 0; k < 128; ++k) { const float w = wp[(size_t)k * NMODC];
#pragma unroll
                for (int j = 0; j < 17; ++j) accm[j] += w * sl[j * 1024 + wave * 128 + k]; }
#pragma unroll
            for (int j = 0; j < 17; ++j) red[(wave * 17 + j) * 64 + lane] = accm[j];
            __syncthreads();
            for (int i = tid; i < 17 * 64; i += 512) { const int j = i >> 6, l = i & 63; float s = a.in[5][slab * 64 + l];
#pragma unroll
                for (int w = 0; w < 8; ++w) s += red[(w * 17 + j) * 64 + l];
                MOD[(size_t)j * NMODC + slab * 64 + l] = s; }
            __syncthreads();
        }
        {
            LAS float* scr = (LAS float*)(lds + wave * 16384);
            constexpr int I13 = 16 * 176, I2 = 44 * 32, IINM = 16 * 144, IINV = 16 * 32, IGLU = 8 * 16, IPA = 16 * 32, IPS = 8 * 32, IOUT = 16 * 32;
            constexpr int NIT = 2 * I13 + 2 * I2 + IINM + IINV + IGLU + IPA + IPS + IOUT;
            for (int it = gw; it < NIT; it += NW) {
                int r = it;
                if (r < I13) { const int kb = r / 176, nb = r % 176; tr_item(a.in[7], D, 2 * DFF, 64 * kb, src_w13(32 * nb), W13_1, 32 * nb, scr, lane); continue; } r -= I13;
                if (r < I13) { const int kb = r / 176, nb = r % 176; tr_item(a.in[32], D, 2 * DFF, 64 * kb, src_w13(32 * nb), W13_2, 32 * nb, scr, lane); continue; } r -= I13;
                if (r < I2) { const int kb = r / 32, nb = r % 32; tr_item(a.in[8], DFF, D, 64 * kb, 32 * nb, W2_1, 32 * nb, scr, lane); continue; } r -= I2;
                if (r < I2) { const int kb = r / 32, nb = r % 32; tr_item(a.in[33], DFF, D, 64 * kb, 32 * nb, W2_2, 32 * nb, scr, lane); continue; } r -= I2;
                if (r < IINM) { const int kb = r / 144, nb = r % 144; tr_item(a.in[10], D, 5632, 64 * kb, src_winm(32 * nb), WINM, 32 * nb, scr, lane); continue; } r -= IINM;
                if (r < IINV) { const int kb = r / 32, nb = r % 32; tr_item(a.in[10], D, 5632, 64 * kb, 2048 + 32 * nb, WINV, 32 * nb, scr, lane); continue; } r -= IINV;
                if (r < IGLU) { const int kb = r / 16, nb = r % 16; tr_item(a.in[26], 512, 512, 64 * kb, 32 * nb, WGLU, 32 * nb, scr, lane); continue; } r -= IGLU;
                if (r < IPA) { const int kb = r / 32, nb = r % 32; tr_item(a.in[28], D, D, 64 * kb, 32 * nb, WPA, 32 * nb, scr, lane); continue; } r -= IPA;
                if (r < IPS) { const int kb = r / 32, nb = r % 32; tr_item(a.in[29], 512, D, 64 * kb, 32 * nb, WPS, 32 * nb, scr, lane); continue; } r -= IPS;
                { const int kb = r / 32, nb = r % 32; tr_item(a.in[30], D, D, 64 * kb, 32 * nb, WOUT, 32 * nb, scr, lane); }
            }
        }
        for (int i = cb * 512 + tid; i < SEQ * 32; i += G * 512) {
            const int t = i >> 5, f = i & 31; const int pos = f < 16 ? (t >> 6) : (t & 63); const int fi = f & 15;
            const float inv = (float)pow(10000.0, -(double)fi / 16.0); const float ang = (float)pos * inv;
            ROPEC[i] = (float)cos((double)ang); ROPES[i] = (float)sin((double)ang);
        }
        for (int i = cb * 512 + tid; i < 2 * 32 * 64; i += G * 512) {
            const int dg = i >> 6, p = i & 63;
            const double lre = a.in[18][i], lim = a.in[19][i], dt = exp((double)a.in[20][dg]);
            const double mag = exp(lre * dt), ar = mag * cos(lim * dt), ai = mag * sin(lim * dt), den = lre * lre + lim * lim, nr = ar - 1.0;
            const double fr_ = (nr * lre + ai * lim) / den, fi_ = (ai * lre - nr * lim) / den;
            S5AR[i] = (float)ar; S5AI[i] = (float)ai;
            const float* bre = a.in[21] + (size_t)i * 16; const float* bim = a.in[22] + (size_t)i * 16;
#pragma unroll
            for (int c2 = 0; c2 < 16; c2 += 2) {
                const double r0 = fr_ * bre[c2] - fi_ * bim[c2], r1 = fr_ * bre[c2 + 1] - fi_ * bim[c2 + 1], i0 = fr_ * bim[c2] + fi_ * bre[c2], i1 = fr_ * bim[c2 + 1] + fi_ * bre[c2 + 1];
                *(unsigned*)(SBB + ((size_t)dg * 128 + 64 * (p >> 5) + (p & 31)) * 16 + c2) = pk2((float)r0, (float)r1);
                *(unsigned*)(SBB + ((size_t)dg * 128 + 64 * (p >> 5) + 32 + (p & 31)) * 16 + c2) = pk2((float)i0, (float)i1);
            }
        }
        for (int i = cb * 512 + tid; i < 2 * 32 * 16 * 64; i += G * 512) {
            const int p2 = (i & 31) * 2, dgc = i >> 5;
            if (i < 2 * 32 * 16 * 32) {
                const float* cre = a.in[23] + (size_t)dgc * 64; const float* cim = a.in[24] + (size_t)dgc * 64;
                *(unsigned*)(SCM + (size_t)dgc * 128 + 2 * p2) = pk2(cre[p2], -cim[p2]);
                *(unsigned*)(SCM + (size_t)dgc * 128 + 2 * p2 + 2) = pk2(cre[p2 + 1], -cim[p2 + 1]);
            }
        }
        if (cb == 0 && tid == 0) {
            float s1 = 0.f, s2 = 0.f;
            for (int i = 0; i < 64; ++i) { s1 += a.in[13][i] * a.in[14][i]; s2 += a.in[15][i] * a.in[16][i]; }
            LAMP[0] = expf(s1) - expf(s2) + 0.2f;
            float gq = 0.f, gk = 0.f;
            for (int i = 0; i < 64; ++i) { gq = fmaxf(gq, fabsf(a.in[11][i])); gk = fmaxf(gk, fabsf(a.in[12][i])); }
            LAMP[1] = 1.02f * 64.f * gq * gk * QSCALE;
        }
    }
    GSYNC(0);

    auto norm_phase = [&](const float* srcX, const float* srcC, int nrows, const float* gain, int sh_chunk, int sc_chunk) {
        const int nchunk = nrows / 8; const int lane = opq(lane_id());
        for (int ch = gw; ch < nchunk; ch += NW) {
            const int r0 = ch * 8; const int mb = r0 < TX ? (r0 >> 12) : 16;
            f32x4 ga[4], sh[4];
#pragma unroll
            for (int j = 0; j < 4; ++j) { const int c = 4 * lane + 256 * j;
                const f32x4 g4 = *(const f32x4*)(gain + c), sc4 = *(const f32x4*)(MOD + (size_t)mb * NMODC + sc_chunk * D + c);
                ga[j] = g4 * (sc4 + 1.0f); sh[j] = *(const f32x4*)(MOD + (size_t)mb * NMODC + sh_chunk * D + c); }
            for (int rr = 0; rr < 8; ++rr) {
                const int r = r0 + rr;
                const float* xr = r < TX ? srcX + (size_t)r * D : srcC + (size_t)(r - TX) * D;
                f32x4 v[4]; float s = 0.f;
#pragma unroll
                for (int j = 0; j < 4; ++j) { v[j] = *(const f32x4*)(xr + 4 * lane + 256 * j); s += (v[j][0] * v[j][0] + v[j][1] * v[j][1]) + (v[j][2] * v[j][2] + v[j][3] * v[j][3]); }
                const float rstd = rsqrtf(wave_sum(s) * (1.f / D) + EPS);
#pragma unroll
                for (int j = 0; j < 4; ++j) { const f32x4 y = v[j] * rstd * ga[j] + sh[j]; u32x2 w; w.x = pk2(y[0], y[1]); w.y = pk2(y[2], y[3]);
                    *(u32x2*)(HBUF + (size_t)r * D + 4 * lane + 256 * j) = w; }
            }
        }
    };

    PH(1) { norm_phase(Xin, Cin, TT, a.in[6], 0, 1); }
    GSYNC(1);
#ifndef REPG
#define REPG 1
#endif
#pragma unroll 1
    for (int rg = 0; rg < REPG; ++rg)
    PH(2) { pg8::SegOrder S; S.init(272, 22, 0, 0, 0, 1, G, cb); pg8::Gemm g{HBUF, W13_1, D}; EpiSwiglu E{ACT}; pg8::gemm_phase<EpiSwiglu, false>(lds, g, S, E, wave); }
    GSYNC(2);
#pragma unroll 1
    for (int rg = 0; rg < REPG; ++rg)
    PH(3) { pg8::SegOrder S; S.init(272, 4, 0, 0, 0, 1, G, cb); pg8::Gemm g{ACT, W2_1, DFF}; EpiResid E{Xin, Cin, X1, MOD + 2 * D, 0.5f}; pg8::gemm_phase<EpiResid, false>(lds, g, S, E, wave); }
    GSYNC(3);
#ifndef REP56
#define REP56 1
#endif
#pragma unroll 1
    for (int rep56 = 0; rep56 < REP56; ++rep56) {
    PH(4) { norm_phase(X1, X1 + (size_t)TX * D, TT, a.in[9], 3, 4); }
    GSYNC(4);
#ifndef REP5
#define REP5 1
#endif
#pragma unroll 1
    for (int r5 = 0; r5 < REP5; ++r5)
    PH(5) {
        { pg8::SegOrder S; S.init(256, 18, 256, 16, 4, 6, G, cb); pg8::Gemm g{HBUF, WINM, D}; EpiInMain E{QB, KB, UG, GA, GS, a.in[11], a.in[12], ROPEC, ROPES}; pg8::gemm_phase<EpiInMain, false>(lds, g, S, E, wave); }
        { pg8::SegOrder S; S.init(272, 4, 0, 0, 0, 1, G, cb); pg8::Gemm g{HBUF, WINV, D}; EpiInV E{VT}; pg8::gemm_phase<EpiInV, true>(lds, g, S, E, wave); }
    }
    GSYNC(5);

    PH(6) {
        const int lane = opq(lane_id()), tid = wave * 64 + lane;
        const int hh = lane >> 5, l31 = lane & 31;
#ifndef REPS
#define REPS 1
#endif
#pragma unroll 1
        for (int rs = 0; rs < REPS; ++rs)
        for (int si = cb; si < 256; si += G) if (wave < 4) {
            const int task = si * 4 + wave, b = task >> 6, d = (task >> 5) & 1, g = task & 31, dg = d * 32 + g;
            LAS unsigned char* wl = lds + wave * 16896;
            const float ar = S5AR[dg * 64 + lane], ai = S5AI[dg * 64 + lane];
            bf16x8 bfr[4], cfr[4];
#pragma unroll
            for (int nt = 0; nt < 4; ++nt) bfr[nt] = *(const bf16x8*)(SBB + ((size_t)dg * 128 + l31 + 32 * nt) * 16 + 8 * hh);
#pragma unroll
            for (int kk = 0; kk < 4; ++kk) cfr[kk] = *(const bf16x8*)(SCM + ((size_t)dg * 16 + (lane & 15)) * 128 + 32 * kk + 8 * (lane >> 4));
            const bf16_t* ug = UG + (size_t)(b * 32 + g) * LK * 16;
            bf16_t* yo = YB + ((size_t)d * TX + (size_t)b * SEQ) * 512 + g * 16;
            float hr = 0.f, hi = 0.f;
            auto upos = [&](int ch) { const int s = 32 * ch + l31; return d == 0 ? s : (s < LC ? LC - 1 - s : LK + LC - 1 - s); };
            bf16x8 afn = *(const bf16x8*)(ug + (size_t)upos(0) * 16 + 8 * hh);
            for (int ch = 0; ch < LK / 32; ++ch) {
                const bf16x8 af = afn;
                if (ch + 1 < LK / 32) afn = *(const bf16x8*)(ug + (size_t)upos(ch + 1) * 16 + 8 * hh);
                f32x16 bu[4];
#pragma unroll
                for (int nt = 0; nt < 4; ++nt) { f32x16 z;
#pragma unroll
                    for (int q = 0; q < 16; ++q) z[q] = 0.f;
                    bu[nt] = __builtin_amdgcn_mfma_f32_32x32x16_bf16(af, bfr[nt], z, 0, 0, 0); }
                float reA[16], reB[16], imA[16], imB[16];
#pragma unroll
                for (int r = 0; r < 16; ++r) {
                    const auto sr = __builtin_amdgcn_permlane32_swap(__float_as_uint(bu[0][r]), __float_as_uint(bu[2][r]), false, false);
                    const auto si_ = __builtin_amdgcn_permlane32_swap(__float_as_uint(bu[1][r]), __float_as_uint(bu[3][r]), false, false);
                    reA[r] = __uint_as_float(sr[0]); reB[r] = __uint_as_float(sr[1]); imA[r] = __uint_as_float(si_[0]); imB[r] = __uint_as_float(si_[1]);
                }
#pragma unroll
                for (int i = 0; i < 4; ++i) {
#pragma unroll
                    for (int j = 0; j < 4; ++j) { const int t = 8 * i + j;
                        const float nhr = fmaf(-ai, hi, fmaf(ar, hr, reA[4 * i + j])), nhi = fmaf(ai, hr, fmaf(ar, hi, imA[4 * i + j]));
                        hr = nhr; hi = nhi; *(LAS unsigned*)(wl + t * 528 + lane * 4) = pk2(hr, hi); }
#pragma unroll
                    for (int j = 0; j < 4; ++j) { const int t = 8 * i + 4 + j;
                        const float nhr = fmaf(-ai, hi, fmaf(ar, hr, reB[4 * i + j])), nhi = fmaf(ai, hr, fmaf(ar, hi, imB[4 * i + j]));
                        hr = nhr; hi = nhi; *(LAS unsigned*)(wl + t * 528 + lane * 4) = pk2(hr, hi); }
                }
                CFENCE();
                if (ch >= LC / 32) {
#pragma unroll
                    for (int mt = 0; mt < 2; ++mt) {
                        f32x4 y = (f32x4){0.f, 0.f, 0.f, 0.f};
#pragma unroll
                        for (int kk = 0; kk < 4; ++kk) { const bf16x8 hf = *(const LAS bf16x8*)(wl + (16 * mt + (lane & 15)) * 528 + (32 * kk + 8 * (lane >> 4)) * 2);
                            y = __builtin_amdgcn_mfma_f32_16x16x32_bf16(cfr[kk], hf, y, 0, 0, 0); }
                        const int s2 = 32 * ch + 16 * mt + (lane & 15);
                        const int tok = d == 0 ? s2 - LC : (LK - 1 - s2);
                        u32x2 w; w.x = pk2(y[0], y[1]); w.y = pk2(y[2], y[3]);
                        *(u32x2*)(yo + (size_t)tok * 512 + 4 * (lane >> 4)) = w;
                    }
                }
                CFENCE();
            }
        }
        __syncthreads();
        const float negC = __builtin_amdgcn_readfirstlane(__float_as_int(LAMP[1] > 64.f ? -LAMP[1] : 0.f)) == 0 ? 0.f : -LAMP[1];
#ifndef REPA
#define REPA 1
#endif
#pragma unroll 1
        for (int repa = 0; repa < REPA; ++repa)
        for (int ai_ = cb; ai_ < NB * NH * 16 * DBG_ATT; ai_ += G) {
            const int lane = opq(lane_id()), hh = lane >> 5, l31 = lane & 31;
            const int cp = ai_ & 255, jr = ai_ >> 8;
            const int bh = 16 * jr + 2 * (cp & 7) + ((cp >> 3) >> 4), qt = (cp >> 3) & 15;
            const int b = bh >> 3, h = bh & 7;
            const int comp = wave >> 2, rg = wave & 3;
            const size_t row0 = (size_t)b * SEQ + qt * 256 + rg * 64;
            LAS unsigned char* qb_ = lds + 71680 + wave * 9216;
            {
                u32x4 qr[8];
#pragma unroll
                for (int j = 0; j < 8; ++j) { const int q = 8 * j + (lane >> 3), c = lane & 7; qr[j] = *(const u32x4*)(QB + (row0 + q) * D + h * 128 + comp * 64 + c * 8); }
#pragma unroll
                for (int j = 0; j < 8; ++j) { const int q = 8 * j + (lane >> 3), c = lane & 7; *(LAS u32x4*)(qb_ + q * 144 + c * 16) = qr[j]; }
            }
            f32x16 O[2][4];
#pragma unroll
            for (int qs = 0; qs < 2; ++qs)
#pragma unroll
                for (int mt = 0; mt < 4; ++mt)
#pragma unroll
                    for (int q = 0; q < 16; ++q) O[qs][mt][q] = 0.f;
            float lsum[2] = {0.f, 0.f};
            const bf16_t* Kg = KB + (size_t)bh * LK * 128; const bf16_t* Vg = VT + (size_t)bh * NKT * 8192;
            LAS unsigned* stab = (LAS unsigned*)(lds + 145408 + wave * 1536);
#pragma unroll
            for (int i = 0; i < 3; ++i) { const int slot = 64 * (wave + 8 * i) + lane; int key = slot / 17, c = slot % 17; if (c == 16) c = 0; if (key > 63) key = 63; stab[i * 64 + lane] = (unsigned)(key * 256 + c * 16);
                int dv = slot / 9, c2 = slot % 9; if (c2 == 8) c2 = 0; if (dv > 127) dv = 127; stab[(3 + i) * 64 + lane] = (unsigned)(dv * 128 + c2 * 16); }
            constexpr int KBUF = 17408, VBUF = 18432, VOFF = 2 * KBUF;
#define ATT_STAGE(buf, tile) do { _Pragma("unroll") for (int _i = 0; _i < 3; ++_i) { const int _j = wave + 8 * _i; \
                if (_j < 17) __builtin_amdgcn_global_load_lds((const unsigned*)((const char*)Kg + (size_t)(tile) * 16384 + stab[_i * 64 + lane]), (LAS unsigned*)(lds + (buf) * KBUF + _j * 1024), 16, 0, 0); \
                if (_j < 18) __builtin_amdgcn_global_load_lds((const unsigned*)((const char*)Vg + (size_t)(tile) * 16384 + stab[(3 + _i) * 64 + lane]), (LAS unsigned*)(lds + VOFF + (buf) * VBUF + _j * 1024), 16, 0, 0); } } while (0)
#define SOFTMAX_STEP(S, L, P) do { \
            float ps = 0.f; unsigned pw[8]; \
            if (negC != 0.f) { _Pragma("unroll") for (int q = 0; q < 16; ++q) S[q] += negC; } \
            _Pragma("unroll") for (int q = 0; q < 16; q += 2) { const float e0 = fexp2(S[q]), e1 = fexp2(S[q + 1]); ps += e0 + e1; pw[q >> 1] = pk2(e0, e1); } \
            L += ps; \
            { u32x4 t0 = (u32x4){pw[0], pw[1], pw[2], pw[3]}, t1 = (u32x4){pw[4], pw[5], pw[6], pw[7]}; P[0] = __builtin_bit_cast(bf16x8, t0); P[1] = __builtin_bit_cast(bf16x8, t1); } } while (0)
#define ATT_BAR() do { asm volatile("s_waitcnt lgkmcnt(0)" ::: "memory"); __builtin_amdgcn_s_barrier(); asm volatile("" ::: "memory"); } while (0)
            ATT_STAGE(0, 0);
            asm volatile("s_waitcnt vmcnt(0)" ::: "memory");
            __syncthreads();
            for (int it = 0; it < NKT; ++it) {
                const int cur = it & 1;
                LAS unsigned char* kb_ = lds + cur * KBUF + l31 * 272 + hh * 16 + comp * 128; LAS unsigned char* vb_ = lds + VOFF + cur * VBUF + l31 * 144 + hh * 16;
                LAS unsigned char* qa_ = qb_ + l31 * 144 + hh * 16;
                f32x16 sA0, sA1, sB0, sB1;
#pragma unroll
                for (int q = 0; q < 16; ++q) { sA0[q] = 0.f; sA1[q] = 0.f; sB0[q] = 0.f; sB1[q] = 0.f; }
#pragma unroll
                for (int kk = 0; kk < 4; ++kk) {
                    const bf16x8 kf = *(const LAS bf16x8*)(kb_ + kk * 32);
                    const bf16x8 q0 = *(const LAS bf16x8*)(qa_ + kk * 32), q1 = *(const LAS bf16x8*)(qa_ + 32 * 144 + kk * 32);
                    sA0 = __builtin_amdgcn_mfma_f32_32x32x16_bf16(kf, q0, sA0, 0, 0, 0);
                    sA1 = __builtin_amdgcn_mfma_f32_32x32x16_bf16(kf, q1, sA1, 0, 0, 0);
                }
#pragma unroll
                for (int kk = 0; kk < 4; ++kk) {
                    const bf16x8 kf = *(const LAS bf16x8*)(kb_ + 32 * 272 + kk * 32);
                    const bf16x8 q0 = *(const LAS bf16x8*)(qa_ + kk * 32), q1 = *(const LAS bf16x8*)(qa_ + 32 * 144 + kk * 32);
                    sB0 = __builtin_amdgcn_mfma_f32_32x32x16_bf16(kf, q0, sB0, 0, 0, 0);
                    sB1 = __builtin_amdgcn_mfma_f32_32x32x16_bf16(kf, q1, sB1, 0, 0, 0);
                }
                bf16x8 pA[2][2], pB[2][2];
                SOFTMAX_STEP(sA0, lsum[0], pA[0]);
                SOFTMAX_STEP(sA1, lsum[1], pA[1]);
#pragma unroll
                for (int s = 0; s < 2; ++s) {
                    if (s == 1 && it + 1 < NKT) ATT_STAGE(cur ^ 1, it + 1);
#pragma unroll
                    for (int mt = 0; mt < 4; ++mt) {
                        const bf16x8 vf = *(const LAS bf16x8*)(vb_ + mt * (32 * 144) + (2 * s) * 16);
                        O[0][mt] = __builtin_amdgcn_mfma_f32_32x32x16_bf16(vf, pA[0][s], O[0][mt], 0, 0, 0);
                        O[1][mt] = __builtin_amdgcn_mfma_f32_32x32x16_bf16(vf, pA[1][s], O[1][mt], 0, 0, 0);
                    }
                }
                SOFTMAX_STEP(sB0, lsum[0], pB[0]);
                SOFTMAX_STEP(sB1, lsum[1], pB[1]);
#pragma unroll
                for (int s = 0; s < 2; ++s)
#pragma unroll
                    for (int mt = 0; mt < 4; ++mt) {
                        const bf16x8 vf = *(const LAS bf16x8*)(vb_ + mt * (32 * 144) + (4 + 2 * s) * 16);
                        O[0][mt] = __builtin_amdgcn_mfma_f32_32x32x16_bf16(vf, pB[0][s], O[0][mt], 0, 0, 0);
                        O[1][mt] = __builtin_amdgcn_mfma_f32_32x32x16_bf16(vf, pB[1][s], O[1][mt], 0, 0, 0);
                    }
                asm volatile("s_waitcnt vmcnt(0)" ::: "memory"); ATT_BAR();
            }
            const int lane2 = opq(lane_id()), hh2 = lane2 >> 5, l31b = lane2 & 31;
            lsum[0] += __shfl_xor(lsum[0], 32); lsum[1] += __shfl_xor(lsum[1], 32);
            LAS float* xb = (LAS float*)(lds + rg * 32768) + lane2;
            if (comp == 1) {
                const float lam = LAMP[0];
#pragma unroll
                for (int qs = 0; qs < 2; ++qs) { const float sc = lam * frcp(lsum[qs]);
#pragma unroll
                    for (int mt = 0; mt < 4; ++mt)
#pragma unroll
                        for (int q = 0; q < 16; ++q) xb[((qs * 4 + mt) * 16 + q) * 64] = O[qs][mt][q] * sc; }
            }
            __syncthreads();
            if (comp == 0) {
#pragma unroll
                for (int qs = 0; qs < 2; ++qs) {
                    const float i0 = frcp(lsum[qs]); float ss = 0.f;
#pragma unroll
                    for (int mt = 0; mt < 4; ++mt)
#pragma unroll
                        for (int q = 0; q < 16; ++q) { const float o = O[qs][mt][q] * i0 - xb[((qs * 4 + mt) * 16 + q) * 64]; O[qs][mt][q] = o; ss += o * o; }
                    ss += __shfl_xor(ss, 32);
                    const float rstd = rsqrtf(ss * (1.f / 128.f) + EPS) * 0.8f;
                    bf16_t* op = QB + (row0 + 32 * qs + l31b) * D + h * 128 + 4 * hh2;
#pragma unroll
                    for (int mt = 0; mt < 4; ++mt)
#pragma unroll
                        for (int q4 = 0; q4 < 4; ++q4) {
                            const f32x4 sg = *(const f32x4*)(a.in[17] + 32 * mt + 8 * q4 + 4 * hh2);
                            u32x2 w; w.x = pk2(O[qs][mt][4 * q4] * rstd * sg[0], O[qs][mt][4 * q4 + 1] * rstd * sg[1]); w.y = pk2(O[qs][mt][4 * q4 + 2] * rstd * sg[2], O[qs][mt][4 * q4 + 3] * rstd * sg[3]);
                            *(u32x2*)(op + 32 * mt + 8 * q4) = w;
                        }
                }
            }
            __syncthreads();
        }
    }
    GSYNC(6);
    }

#define BSYNC() do { asm volatile("s_waitcnt vmcnt(0) lgkmcnt(0)" ::: "memory"); __syncthreads(); \
        if (wave == 0) { __builtin_amdgcn_fence(__ATOMIC_ACQUIRE, "agent"); asm volatile("s_waitcnt vmcnt(0) lgkmcnt(0)" ::: "memory"); } __syncthreads(); } while (0)
    PH(7) {
        for (int pm = cb; pm < TX / 256; pm += G) {
            {
                const int tid = wave * 64 + opq(lane_id());
                for (int i = tid; i < 256 * 64; i += 512) {
                    const size_t tok = (size_t)pm * 256 + (i >> 6); const int j = i & 63, ch0 = 8 * j, g = j >> 1, c0 = 8 * (j & 1);
                    const int b = (int)(tok >> 12), t = (int)(tok & (SEQ - 1));
                    const u32x4 y0 = *(const u32x4*)(YB + tok * 512 + ch0), y1 = *(const u32x4*)(YB + ((size_t)TX + tok) * 512 + ch0);
                    const u32x4 uu = *(const u32x4*)(UG + ((size_t)(b * 32 + g) * LK + LC + t) * 16 + c0);
                    const f32x4 d0 = *(const f32x4*)(a.in[25] + ch0), d1 = *(const f32x4*)(a.in[25] + ch0 + 4);
                    u32x4 w;
                    w.x = pk2(gelu_tanh(bflo(y0.x) + bflo(y1.x) + d0[0] * bflo(uu.x)), gelu_tanh(bfhi(y0.x) + bfhi(y1.x) + d0[1] * bfhi(uu.x)));
                    w.y = pk2(gelu_tanh(bflo(y0.y) + bflo(y1.y) + d0[2] * bflo(uu.y)), gelu_tanh(bfhi(y0.y) + bfhi(y1.y) + d0[3] * bfhi(uu.y)));
                    w.z = pk2(gelu_tanh(bflo(y0.z) + bflo(y1.z) + d1[0] * bflo(uu.z)), gelu_tanh(bfhi(y0.z) + bfhi(y1.z) + d1[1] * bfhi(uu.z)));
                    w.w = pk2(gelu_tanh(bflo(y0.w) + bflo(y1.w) + d1[2] * bflo(uu.w)), gelu_tanh(bfhi(y0.w) + bfhi(y1.w) + d1[3] * bfhi(uu.w)));
                    *(u32x4*)(YG + tok * 512 + ch0) = w;
                }
            }
            BSYNC();
            { pg8::SegOrder S; S.init(0, 1, pm, 1, 0, 2, 1, 0); pg8::Gemm g{YG, WGLU, 512}; EpiGlu E{YG, SX, a.in[27]}; pg8::gemm_phase<EpiGlu, false>(lds, g, S, E, wave); }
            BSYNC();
            { pg8::SegOrder S; S.init(0, 1, pm, 1, 0, 4, 1, 0); pg8::Gemm g{SX, WPS, 512}; EpiMerge<false> E{GS, MBUF}; pg8::gemm_phase<EpiMerge<false>, false>(lds, g, S, E, wave); }
            BSYNC();
            { pg8::SegOrder S; S.init(0, 1, pm, 1, 0, 4, 1, 0); pg8::Gemm g{QB, WPA, D}; EpiMerge<true> E{GA, MBUF}; pg8::gemm_phase<EpiMerge<true>, false>(lds, g, S, E, wave); }
            BSYNC();
            { pg8::SegOrder S; S.init(0, 1, pm, 1, 0, 4, 1, 0); pg8::Gemm g{MBUF, WOUT, D}; EpiResid E{X1, X1, X1, MOD + 5 * D, 1.0f}; pg8::gemm_phase<EpiResid, false>(lds, g, S, E, wave); }
            BSYNC();
            {
                const int lane = opq(lane_id()); const int mb = pm >> 4;
                f32x4 ga[4], sh[4];
#pragma unroll
                for (int j = 0; j < 4; ++j) { const int c = 4 * lane + 256 * j;
                    const f32x4 g4 = *(const f32x4*)(a.in[31] + c), sc4 = *(const f32x4*)(MOD + (size_t)mb * NMODC + 7 * D + c);
                    ga[j] = g4 * (sc4 + 1.0f); sh[j] = *(const f32x4*)(MOD + (size_t)mb * NMODC + 6 * D + c); }
                for (int rr = wave; rr < 256; rr += 8) {
                    const size_t r = (size_t)pm * 256 + rr;
                    const float* xr = X1 + r * D;
                    f32x4 v[4]; float s2 = 0.f;
#pragma unroll
                    for (int j = 0; j < 4; ++j) { v[j] = *(const f32x4*)(xr + 4 * lane + 256 * j); s2 += (v[j][0] * v[j][0] + v[j][1] * v[j][1]) + (v[j][2] * v[j][2] + v[j][3] * v[j][3]); }
                    const float rstd = rsqrtf(wave_sum(s2) * (1.f / D) + EPS);
#pragma unroll
                    for (int j = 0; j < 4; ++j) { const f32x4 y = v[j] * rstd * ga[j] + sh[j]; u32x2 w; w.x = pk2(y[0], y[1]); w.y = pk2(y[2], y[3]);
                        *(u32x2*)(GA + r * D + 4 * lane + 256 * j) = w; }
                }
            }
            if (pm + G < TX / 256) BSYNC();
        }
    }
    GSYNC(7);
#pragma unroll 1
    for (int rg = 0; rg < REPG; ++rg)
    PH(13) { pg8::SegOrder S; S.init(256, 22, 0, 0, 0, 1, G, cb); pg8::Gemm g{GA, W13_2, D}; EpiSwiglu E{ACT}; pg8::gemm_phase<EpiSwiglu, false>(lds, g, S, E, wave); }
    GSYNC(13);
    PH(14) { pg8::SegOrder S; S.init(256, 4, 0, 0, 0, 1, G, cb); pg8::Gemm g{ACT, W2_2, DFF}; EpiResid E{X1, X1, a.out, MOD + 8 * D, 0.5f}; pg8::gemm_phase<EpiResid, false>(lds, g, S, E, wave); }
}

extern "C" void kernel_launch(void* const* d_in, const int* in_sizes, int n_in, void* d_out, int out_size, void* d_ws, size_t ws_size, hipStream_t stream) {
    static int grid = 0;
    if (grid == 0) {
        if (n_in != 34 || out_size != TX * D || ws_size < WS_END) { fprintf(stderr, "kernel_launch: unexpected shapes (n_in %d, out %d, ws %zu < %zu)\n", n_in, out_size, ws_size, (size_t)WS_END); grid = -1; return; }
        int dev = 0, cus = 0, per_cu = 0;
        hipGetDevice(&dev); hipDeviceGetAttribute(&cus, hipDeviceAttributeMultiprocessorCount, dev);
        if (hipFuncSetAttribute((const void*)mega, hipFuncAttributeMaxDynamicSharedMemorySize, LDS_BYTES) != hipSuccess) { fprintf(stderr, "kernel_launch: hipFuncSetAttribute failed\n"); grid = -1; return; }
        if (hipOccupancyMaxActiveBlocksPerMultiprocessor(&per_cu, (const void*)mega, 512, LDS_BYTES) != hipSuccess || per_cu < 1) { fprintf(stderr, "kernel_launch: occupancy query says %d\n", per_cu); per_cu = 1; }
        (void)hipGetLastError();
        grid = cus;
    }
    if (grid < 0) return;
    Args a{};
    for (int i = 0; i < 34; ++i) a.in[i] = (const float*)d_in[i];
    a.out = (float*)d_out; a.ws = (unsigned char*)d_ws;
#if MK_SPLIT
    for (int p = 0; p < NPHASE; ++p) { a.ph_lo = p; a.ph_hi = p + 1; hipLaunchKernelGGL(mega, dim3(grid), dim3(512), LDS_BYTES, stream, a); }
#else
    a.ph_lo = 0; a.ph_hi = NPHASE;
    if (hipMemsetAsync((unsigned char*)d_ws + WS_BAR, 0, 256, stream) != hipSuccess) { fprintf(stderr, "kernel_launch: memset of the barrier word failed\n"); return; }
    void* args[] = {&a};
    hipError_t e = hipLaunchCooperativeKernel((const void*)mega, dim3(grid), dim3(512), args, LDS_BYTES, stream);
    if (e != hipSuccess) fprintf(stderr, "cooperative launch failed: %s (grid %d)\n", hipGetErrorString(e), grid);
#endif
}
```

```cpp
#include <hip/hip_runtime.h>
#include <hip/hip_cooperative_groups.h>
#include <cstdio>
#include <cstdint>
namespace cg = cooperative_groups;

#define LAS __attribute__((address_space(3)))
typedef unsigned short bf16_t;
typedef short bf16x8 __attribute__((ext_vector_type(8)));
typedef float f32x4 __attribute__((ext_vector_type(4)));
typedef float f32x16 __attribute__((ext_vector_type(16)));
typedef unsigned u32x4 __attribute__((ext_vector_type(4)));
typedef unsigned u32x2 __attribute__((ext_vector_type(2)));

#define DBG_ATT 1
#define REPG 1
#define REP5 1
#ifndef MK_SPLIT
#define MK_SPLIT 0
#endif

constexpr int D = 1024, NB = 16, SEQ = 4096, LC = 256, LK = SEQ + LC, TX = NB * SEQ, TC = NB * LC, TT = TX + TC;
constexpr int NH = 8, DFF = 2816, NMODC = 9 * D, NKT = LK / 64;
constexpr int NPHASE = 15;
constexpr float EPS = 1e-6f;
constexpr float QSCALE = 0.125f * 1.4426950408889634f;

constexpr size_t al256(size_t x) { return (x + 255) & ~(size_t)255; }
constexpr size_t WS_W13_1 = 0;
constexpr size_t WS_W2_1 = WS_W13_1 + (size_t)2 * DFF * D * 2;
constexpr size_t WS_WIN_M = WS_W2_1 + (size_t)D * DFF * 2;
constexpr size_t WS_WIN_V = WS_WIN_M + (size_t)4608 * D * 2;
constexpr size_t WS_WGLU = WS_WIN_V + (size_t)D * D * 2;
constexpr size_t WS_WPA = WS_WGLU + (size_t)512 * 512 * 2;
constexpr size_t WS_WPS = WS_WPA + (size_t)D * D * 2;
constexpr size_t WS_WOUT = WS_WPS + (size_t)D * 512 * 2;
constexpr size_t WS_W13_2 = WS_WOUT + (size_t)D * D * 2;
constexpr size_t WS_W2_2 = WS_W13_2 + (size_t)2 * DFF * D * 2;
constexpr size_t WS_MOD = WS_W2_2 + (size_t)D * DFF * 2;
constexpr size_t WS_ROPE = al256(WS_MOD + (size_t)17 * NMODC * 4);
constexpr size_t WS_S5A = WS_ROPE + (size_t)2 * SEQ * 32 * 4;
constexpr size_t WS_SBB = WS_S5A + (size_t)2 * 2 * 32 * 64 * 4;
constexpr size_t WS_SCM = WS_SBB + (size_t)2 * 32 * 128 * 16 * 2;
constexpr size_t WS_LAM = WS_SCM + (size_t)2 * 32 * 16 * 128 * 2;
constexpr size_t WS_BAR = WS_LAM + 256;
constexpr size_t WS_X1 = al256(WS_BAR + 256);
constexpr size_t WS_HBUF = WS_X1 + (size_t)TT * D * 4;
constexpr size_t WS_ACT = WS_HBUF + (size_t)TT * D * 2;
constexpr size_t WS_VT = WS_ACT + (size_t)TT * DFF * 2;
constexpr size_t WS_END = WS_VT + (size_t)NB * NH * LK * 128 * 2;
constexpr size_t WS_Y = WS_HBUF;
constexpr size_t WS_QB = WS_ACT;
constexpr size_t WS_KB = WS_QB + (size_t)TX * D * 2;
constexpr size_t WS_UG = WS_KB + (size_t)NB * NH * LK * 128 * 2;
constexpr size_t WS_YG = WS_KB;
constexpr size_t WS_SX = WS_KB + (size_t)TX * 512 * 2;
constexpr size_t WS_MBUF = WS_VT;
static_assert(WS_UG + (size_t)NB * 32 * LK * 16 * 2 <= WS_VT, "overlay overflow");
static_assert(WS_SX + (size_t)TX * 512 * 2 <= WS_UG, "overlay overflow");

constexpr int LDS_BYTES = 157696;

struct Args { const float* in[34]; float* out; unsigned char* ws; int ph_lo, ph_hi; };

typedef __bf16 bf16x2_t __attribute__((ext_vector_type(2)));
typedef float f32x2_t __attribute__((ext_vector_type(2)));
__device__ __forceinline__ unsigned pk2(float lo, float hi) { f32x2_t v = {lo, hi}; bf16x2_t r = __builtin_convertvector(v, bf16x2_t); return __builtin_bit_cast(unsigned, r); }
__device__ __forceinline__ float bf2f(unsigned short b) { return __uint_as_float(((unsigned)b) << 16); }
__device__ __forceinline__ float bflo(unsigned w) { return __uint_as_float(w << 16); }
__device__ __forceinline__ float bfhi(unsigned w) { return __uint_as_float(w & 0xffff0000u); }
__device__ __forceinline__ float fexp2(float x) { return __builtin_amdgcn_exp2f(x); }
__device__ __forceinline__ float frcp(float x) { return __builtin_amdgcn_rcpf(x); }
__device__ __forceinline__ float sigmoidf_(float x) { return frcp(1.f + fexp2(-1.4426950408889634f * x)); }
__device__ __forceinline__ float siluf_(float x) { return x * sigmoidf_(x); }
__device__ __forceinline__ float gelu_tanh(float x) { const float u = 0.7978845608028654f * (x + 0.044715f * x * x * x); return x * sigmoidf_(2.f * u); }
__device__ __forceinline__ float wave_sum(float v) {
#pragma unroll
    for (int o = 1; o < 64; o <<= 1) v += __shfl_xor(v, o);
    return v;
}
__device__ __forceinline__ int opq(int x) { asm volatile("" : "+v"(x)); return x; }
__device__ __forceinline__ int lane_id() { return (int)__builtin_amdgcn_mbcnt_hi(~0u, __builtin_amdgcn_mbcnt_lo(~0u, 0u)); }
#define LDS_WAIT() asm volatile("s_waitcnt lgkmcnt(0)" ::: "memory")
#define CFENCE() asm volatile("" ::: "memory")

namespace pg8 {
constexpr int BM = 256, BK = 64, HALF = 128, HTB = HALF * BK * 2, STAGE_BYTES = 8 * HTB, NXCD = 8, WGM = 8;
__host__ __device__ __forceinline__ int lds_byte(int r, int c) { const int st = (r >> 4) * 2 + (c >> 5), rr = r & 15, cc = c & 31, ob = rr * 64 + cc * 2; return st * 1024 + (ob ^ (((ob >> 9) & 1) << 5)); }
__host__ __device__ __forceinline__ void stage_rc(int b, int& R, int& C) { const int st = b / 1024, sb = b % 1024, swz = sb ^ (((sb >> 9) & 1) << 5); R = (st >> 1) * 16 + swz / 64; C = (st & 1) * 32 + (swz % 64) / 2; }
__host__ __device__ __forceinline__ int perm32(int rho) { const int n = rho >> 4, i = rho & 15; return 8 * (i >> 2) + 4 * n + (i & 3); }
struct Unit { int pm, pn; };
struct Gemm { const bf16_t* A; const bf16_t* Bt; int K; };

struct SegOrder {
    int nM1, nN1, n1, pm2, nM2, pn2, nN2, n2, G, c;
    __device__ __forceinline__ void init(int nM1_, int nN1_, int pm2_, int nM2_, int pn2_, int nN2_, int G_, int c_) {
        nM1 = nM1_; nN1 = nN1_; n1 = nM1 * nN1; pm2 = pm2_; nM2 = nM2_; pn2 = pn2_; nN2 = nN2_; n2 = nM2 * nN2; G = G_; c = c_; }
    __device__ __forceinline__ bool next(int i, Unit& u) const {
        long L = (long)i * G + c;
        if (L < n1) {
            int wgid = (int)L; { const int q = n1 / NXCD, r = n1 % NXCD, xcd = wgid % NXCD, off = wgid / NXCD; wgid = (xcd < r ? xcd * (q + 1) : r * (q + 1) + (xcd - r) * q) + off; }
            const int nig = WGM * nN1, gid = wgid / nig, fm = gid * WGM, gsz = (nM1 - fm) < WGM ? (nM1 - fm) : WGM;
            u.pm = fm + ((wgid % nig) % gsz); u.pn = (wgid % nig) / gsz; return true;
        }
        L -= n1; if (L >= n2) return false;
        u.pm = pm2 + (int)(L / nN2); u.pn = pn2 + (int)(L % nN2); return true;
    }
};

template <class Epi, bool SWAP>
__device__ __forceinline__ void gemm_phase(LAS unsigned char* lds, const Gemm g, const SegOrder& S, const Epi& E, int wid) {
    const int lane = opq(lane_id()), tid = wid * 64 + lane, wr = wid >> 2, wc = wid & 3, fr = lane & 15, fq = lane >> 4;
    const int K = g.K, nt = K / BK;
    unsigned voffA[2], voffB[2];
#pragma unroll
    for (int i = 0; i < 2; ++i) { int R, C; stage_rc(tid * 16 + i * 8192, R, C); const int Rb = Epi::PERM ? ((R & ~31) + perm32(R & 31)) : R;
        voffA[i] = (unsigned)(R * K + C) * 2u; voffB[i] = (unsigned)(Rb * K + C) * 2u; }
    const size_t kstep = (size_t)(BK * 2);
    const size_t hstep = (size_t)HALF * K * 2;
    const size_t tstep = 2 * hstep;
    const unsigned ldsw = (unsigned)wid * 1024u;
    const int aoff = lds_byte(wr * 64 + fr, fq * 8), boff = lds_byte(wc * 32 + fr, fq * 8);
#define PG8_SA(b, h) (((b) * 2 + (h)) * HTB)
#define PG8_SB(b, h) ((4 + (b) * 2 + (h)) * HTB)
#define PG8_STAGE(bufoff, gbase, voff) do { _Pragma("unroll") for (int _i = 0; _i < 2; ++_i) \
        __builtin_amdgcn_global_load_lds((const unsigned*)((const char*)(gbase) + (voff)[_i]), (LAS unsigned*)(lds + (bufoff) + ldsw + _i * 8192), 16, 0, 0); } while (0)
#define PG8_LDA(dst, b, h) do { _Pragma("unroll") for (int m = 0; m < 4; ++m) _Pragma("unroll") for (int k = 0; k < 2; ++k) dst[m][k] = *(const LAS bf16x8*)(lds + PG8_SA(b, h) + aoff + m * 2048 + k * 1024); } while (0)
#define PG8_LDB(dst, b, h) do { _Pragma("unroll") for (int n = 0; n < 2; ++n) _Pragma("unroll") for (int k = 0; k < 2; ++k) dst[n][k] = *(const LAS bf16x8*)(lds + PG8_SB(b, h) + boff + n * 2048 + k * 1024); } while (0)
#define PG8_MMA(ai, bj, At, Bt) do { __builtin_amdgcn_s_setprio(1); _Pragma("unroll") for (int m = 0; m < 4; ++m) _Pragma("unroll") for (int n = 0; n < 2; ++n) _Pragma("unroll") for (int k = 0; k < 2; ++k) \
        acc[ai][bj][m][n] = SWAP ? __builtin_amdgcn_mfma_f32_16x16x32_bf16(At[m][k], Bt[n][k], acc[ai][bj][m][n], 0, 0, 0) \
                                 : __builtin_amdgcn_mfma_f32_16x16x32_bf16(Bt[n][k], At[m][k], acc[ai][bj][m][n], 0, 0, 0); __builtin_amdgcn_s_setprio(0); } while (0)
#define PG8_WAIT_V(n) asm volatile("s_waitcnt vmcnt(" #n ")" ::: "memory")
#define PG8_WAIT_L(n) asm volatile("s_waitcnt lgkmcnt(" #n ")" ::: "memory")
#define PG8_BAR __builtin_amdgcn_s_barrier()
#define PG8_SCHED __builtin_amdgcn_sched_barrier(0)
    Unit cur, nxt; int ui = 0;
    if (!S.next(0, cur)) return;
    f32x4 acc[2][2][4][2];
#pragma unroll
    for (int a = 0; a < 2; ++a)
#pragma unroll
        for (int b = 0; b < 2; ++b)
#pragma unroll
            for (int m = 0; m < 4; ++m)
#pragma unroll
                for (int n = 0; n < 2; ++n) acc[a][b][m][n] = (f32x4){0.f, 0.f, 0.f, 0.f};
    bf16x8 At[4][2], B0[2][2], B1[2][2];
    const char* cA = (const char*)g.A + (size_t)cur.pm * tstep; const char* cB = (const char*)g.Bt + (size_t)cur.pn * tstep;
    PG8_STAGE(PG8_SB(0, 0), cB, voffB); PG8_STAGE(PG8_SB(0, 1), cB + hstep, voffB); PG8_STAGE(PG8_SA(0, 0), cA, voffA); PG8_STAGE(PG8_SA(0, 1), cA + hstep, voffA);
    if (wr == 1) PG8_BAR;
    PG8_WAIT_V(2); PG8_BAR;
    PG8_STAGE(PG8_SB(1, 0), cB + kstep, voffB); PG8_STAGE(PG8_SA(1, 0), cA + kstep, voffA); PG8_STAGE(PG8_SB(1, 1), cB + hstep + kstep, voffB);
    PG8_WAIT_V(6); PG8_BAR;
    for (;;) {
        const bool has_next = S.next(ui + 1, nxt);
        const char* nA = has_next ? (const char*)g.A + (size_t)nxt.pm * tstep : cA; const char* nB = has_next ? (const char*)g.Bt + (size_t)nxt.pn * tstep : cB;
        for (int t = 0; t < nt; t += 2) {
            const bool last = (t == nt - 2);
            const char* a1 = cA + (size_t)(t + 1) * kstep;
            const char* a2 = last ? nA : cA + (size_t)(t + 2) * kstep; const char* b2 = last ? nB : cB + (size_t)(t + 2) * kstep;
            const char* a3 = a2 + kstep; const char* b3 = b2 + kstep;
            PG8_LDB(B0, 0, 0); PG8_LDB(B1, 0, 1); PG8_SCHED; PG8_LDA(At, 0, 0); PG8_STAGE(PG8_SA(1, 1), a1 + hstep, voffA);
            PG8_WAIT_V(8); PG8_WAIT_L(0); PG8_BAR; PG8_MMA(0, 0, At, B0); PG8_MMA(0, 1, At, B1); PG8_BAR; PG8_SCHED;
            PG8_LDA(At, 0, 1); PG8_STAGE(PG8_SB(0, 0), b2, voffB); PG8_STAGE(PG8_SB(0, 1), b2 + hstep, voffB); PG8_STAGE(PG8_SA(0, 0), a2, voffA);
            PG8_WAIT_V(8); PG8_WAIT_L(0); PG8_BAR; PG8_MMA(1, 0, At, B0); PG8_MMA(1, 1, At, B1); PG8_BAR; PG8_SCHED;
            PG8_LDB(B0, 1, 0); PG8_LDB(B1, 1, 1); PG8_SCHED; PG8_LDA(At, 1, 0); PG8_STAGE(PG8_SA(0, 1), a2 + hstep, voffA);
            PG8_WAIT_V(8); PG8_WAIT_L(0); PG8_BAR; PG8_MMA(0, 0, At, B0); PG8_MMA(0, 1, At, B1); PG8_BAR; PG8_SCHED;
            PG8_LDA(At, 1, 1); PG8_STAGE(PG8_SB(1, 0), b3, voffB); PG8_STAGE(PG8_SB(1, 1), b3 + hstep, voffB); PG8_STAGE(PG8_SA(1, 0), a3, voffA);
            PG8_WAIT_V(8); PG8_WAIT_L(0); PG8_BAR; PG8_MMA(1, 0, At, B0); PG8_MMA(1, 1, At, B1); PG8_BAR; PG8_SCHED;
        }
        if (wr == 0) PG8_BAR;
        E(acc, cur, wr, wc, fr, fq);
        if (!has_next) break;
#pragma unroll
        for (int a = 0; a < 2; ++a)
#pragma unroll
            for (int b = 0; b < 2; ++b)
#pragma unroll
                for (int m = 0; m < 4; ++m)
#pragma unroll
                    for (int n = 0; n < 2; ++n) acc[a][b][m][n] = (f32x4){0.f, 0.f, 0.f, 0.f};
        cur = nxt; cA = nA; cB = nB; ++ui;
        if (wr == 1) PG8_BAR;
    }
    PG8_WAIT_V(0);
    PG8_BAR;
#undef PG8_SA
#undef PG8_SB
#undef PG8_STAGE
#undef PG8_LDA
#undef PG8_LDB
#undef PG8_MMA
#undef PG8_WAIT_V
#undef PG8_WAIT_L
#undef PG8_BAR
#undef PG8_SCHED
}
}
using pg8::Unit;


struct EpiSwiglu {
    static constexpr bool PERM = true;
    bf16_t* O;
    __device__ __forceinline__ void operator()(const f32x4 (&acc)[2][2][4][2], const Unit& u, int wr, int wc, int fr, int fq) const {
        const int row0 = u.pm * 256 + wr * 64 + fr, col0 = u.pn * 128 + wc * 32 + 8 * fq;
#pragma unroll
        for (int ai = 0; ai < 2; ++ai)
#pragma unroll
            for (int m = 0; m < 4; ++m) {
                const f32x4 a0 = acc[ai][0][m][0], a1 = acc[ai][0][m][1], b0 = acc[ai][1][m][0], b1 = acc[ai][1][m][1];
                u32x4 w;
                w.x = pk2(siluf_(a0[0]) * b0[0], siluf_(a0[1]) * b0[1]); w.y = pk2(siluf_(a0[2]) * b0[2], siluf_(a0[3]) * b0[3]);
                w.z = pk2(siluf_(a1[0]) * b1[0], siluf_(a1[1]) * b1[1]); w.w = pk2(siluf_(a1[2]) * b1[2], siluf_(a1[3]) * b1[3]);
                *(u32x4*)(O + (size_t)(row0 + ai * 128 + m * 16) * DFF + col0) = w;
            }
    }
};

struct EpiResid {
    static constexpr bool PERM = false;
    const float* srcX; const float* srcC; float* dst; const float* gate; float coef;
    __device__ __forceinline__ void operator()(const f32x4 (&acc)[2][2][4][2], const Unit& u, int wr, int wc, int fr, int fq) const {
        const int mb = u.pm < 256 ? (u.pm >> 4) : 16;
        const float* sp = u.pm < 256 ? srcX + (size_t)u.pm * 256 * D : srcC + (size_t)(u.pm - 256) * 256 * D;
        float* dp = dst + (size_t)u.pm * 256 * D;
        const int rl = wr * 64 + fr, col0 = u.pn * 256 + wc * 32 + 4 * fq;
        f32x4 gv[2][2];
#pragma unroll
        for (int bj = 0; bj < 2; ++bj)
#pragma unroll
            for (int n = 0; n < 2; ++n) gv[bj][n] = *(const f32x4*)(gate + (size_t)mb * NMODC + col0 + bj * 128 + n * 16) * coef;
#pragma unroll
        for (int ai = 0; ai < 2; ++ai)
#pragma unroll
            for (int m = 0; m < 4; ++m) {
                const size_t ro = (size_t)(rl + ai * 128 + m * 16) * D + col0;
#pragma unroll
                for (int bj = 0; bj < 2; ++bj)
#pragma unroll
                    for (int n = 0; n < 2; ++n) { const f32x4 s = *(const f32x4*)(sp + ro + bj * 128 + n * 16); *(f32x4*)(dp + ro + bj * 128 + n * 16) = s + gv[bj][n] * acc[ai][bj][m][n]; }
            }
    }
};

struct EpiInMain {
    static constexpr bool PERM = true;
    bf16_t* QB; bf16_t* KB; bf16_t* UG; bf16_t* GA; bf16_t* GS; const float* qn; const float* kn; const float* ropec; const float* ropes;
    __device__ __forceinline__ void operator()(const f32x4 (&acc)[2][2][4][2], const Unit& u, int wr, int wc, int fr, int fq) const {
        const int pn = u.pn; const bool isx = u.pm < 256;
        const int rl = wr * 64 + fr;
        if (pn < 8) {
            const bool isq = pn < 4;
            const float* gn = isq ? qn : kn;
            f32x4 g[2][2];
#pragma unroll
            for (int bj = 0; bj < 2; ++bj)
#pragma unroll
                for (int n = 0; n < 2; ++n) g[bj][n] = *(const f32x4*)(gn + 32 * bj + 8 * fq + 4 * n);
            const int hcg = 4 * (pn & 3) + wc, head = hcg >> 1, comp = hcg & 1;
#pragma unroll
            for (int ai = 0; ai < 2; ++ai)
#pragma unroll
                for (int m = 0; m < 4; ++m) {
                    const int r = u.pm * 256 + rl + ai * 128 + m * 16;
                    f32x4 v[2][2]; float ss = 0.f;
#pragma unroll
                    for (int bj = 0; bj < 2; ++bj)
#pragma unroll
                        for (int n = 0; n < 2; ++n) { v[bj][n] = acc[ai][bj][m][n]; ss += (v[bj][n][0] * v[bj][n][0] + v[bj][n][1] * v[bj][n][1]) + (v[bj][n][2] * v[bj][n][2] + v[bj][n][3] * v[bj][n][3]); }
                    ss += __shfl_xor(ss, 16); ss += __shfl_xor(ss, 32);
                    const float rstd = rsqrtf(ss * (1.f / 64.f) + EPS);
#pragma unroll
                    for (int bj = 0; bj < 2; ++bj)
#pragma unroll
                        for (int n = 0; n < 2; ++n) v[bj][n] = v[bj][n] * rstd * g[bj][n];
                    if (isx) {
                        const int t = r & (SEQ - 1);
#pragma unroll
                        for (int n = 0; n < 2; ++n) {
                            const f32x4 cs = *(const f32x4*)(ropec + t * 32 + 8 * fq + 4 * n), sn = *(const f32x4*)(ropes + t * 32 + 8 * fq + 4 * n);
                            const f32x4 t1 = v[0][n], t2 = v[1][n];
                            v[0][n] = t1 * cs - t2 * sn; v[1][n] = t2 * cs + t1 * sn;
                        }
                    }
                    bf16_t* dstp;
                    if (isq) {
#pragma unroll
                        for (int bj = 0; bj < 2; ++bj)
#pragma unroll
                            for (int n = 0; n < 2; ++n) v[bj][n] = v[bj][n] * QSCALE;
                        dstp = QB + (size_t)r * D + hcg * 64 + 8 * fq;
                    } else {
                        int b, pos; if (isx) { b = r >> 12; pos = LC + (r & (SEQ - 1)); } else { const int rc = r - TX; b = rc >> 8; pos = rc & (LC - 1); }
                        dstp = KB + (((size_t)(b * NH + head) * LK + pos) * 2 + comp) * 64 + 8 * fq;
                    }
#pragma unroll
                    for (int bj = 0; bj < 2; ++bj) {
                        u32x4 w; w.x = pk2(v[bj][0][0], v[bj][0][1]); w.y = pk2(v[bj][0][2], v[bj][0][3]); w.z = pk2(v[bj][1][0], v[bj][1][1]); w.w = pk2(v[bj][1][2], v[bj][1][3]);
                        *(u32x4*)(dstp + 32 * bj) = w;
                    }
                }
        } else if (pn < 10) {
#pragma unroll
            for (int ai = 0; ai < 2; ++ai)
#pragma unroll
                for (int m = 0; m < 4; ++m) {
                    const int r = u.pm * 256 + rl + ai * 128 + m * 16;
                    int b, pos; if (isx) { b = r >> 12; pos = LC + (r & (SEQ - 1)); } else { const int rc = r - TX; b = rc >> 8; pos = rc & (LC - 1); }
#pragma unroll
                    for (int bj = 0; bj < 2; ++bj) {
                        const int ch0 = 256 * (pn - 8) + 128 * bj + 32 * wc + 8 * fq, gidx = ch0 >> 4, c0 = ch0 & 15;
                        const f32x4 v0 = acc[ai][bj][m][0], v1 = acc[ai][bj][m][1];
                        u32x4 w; w.x = pk2(v0[0], v0[1]); w.y = pk2(v0[2], v0[3]); w.z = pk2(v1[0], v1[1]); w.w = pk2(v1[2], v1[3]);
                        *(u32x4*)(UG + ((size_t)(b * 32 + gidx) * LK + pos) * 16 + c0) = w;
                    }
                }
        } else {
            bf16_t* Gd = pn < 14 ? GA : GS; const int pq = pn < 14 ? pn - 10 : pn - 14;
#pragma unroll
            for (int ai = 0; ai < 2; ++ai)
#pragma unroll
                for (int m = 0; m < 4; ++m) {
                    const int r = u.pm * 256 + rl + ai * 128 + m * 16;
#pragma unroll
                    for (int bj = 0; bj < 2; ++bj) {
                        const f32x4 v0 = acc[ai][bj][m][0], v1 = acc[ai][bj][m][1];
                        u32x4 w; w.x = pk2(sigmoidf_(v0[0]), sigmoidf_(v0[1])); w.y = pk2(sigmoidf_(v0[2]), sigmoidf_(v0[3])); w.z = pk2(sigmoidf_(v1[0]), sigmoidf_(v1[1])); w.w = pk2(sigmoidf_(v1[2]), sigmoidf_(v1[3]));
                        *(u32x4*)(Gd + (size_t)r * D + 256 * pq + 128 * bj + 32 * wc + 8 * fq) = w;
                    }
                }
        }
    }
};

struct EpiInV {
    static constexpr bool PERM = false;
    bf16_t* VT;
    __device__ __forceinline__ void operator()(const f32x4 (&acc)[2][2][4][2], const Unit& u, int wr, int wc, int fr, int fq) const {
        const bool isx = u.pm < 256;
#pragma unroll
        for (int ai = 0; ai < 2; ++ai)
#pragma unroll
            for (int m = 0; m < 4; ++m) {
                const int r = u.pm * 256 + ai * 128 + wr * 64 + m * 16 + 4 * fq;
                int b, pos; if (isx) { b = r >> 12; pos = LC + (r & (SEQ - 1)); } else { const int rc = r - TX; b = rc >> 8; pos = rc & (LC - 1); }
                const int tile = pos >> 6, kp = pos & 63, k16 = kp & 15, sp = (kp & 48) + 8 * ((k16 >> 2) & 1) + 4 * (k16 >> 3);
#pragma unroll
                for (int bj = 0; bj < 2; ++bj)
#pragma unroll
                    for (int n = 0; n < 2; ++n) {
                        const int col = u.pn * 256 + bj * 128 + wc * 32 + n * 16 + fr, h = col >> 7, dv = col & 127;
                        const f32x4 v = acc[ai][bj][m][n];
                        u32x2 w; w.x = pk2(v[0], v[1]); w.y = pk2(v[2], v[3]);
                        *(u32x2*)(VT + (((size_t)(b * NH + h) * NKT + tile) * 128 + dv) * 64 + sp) = w;
                    }
            }
    }
};

struct EpiGlu {
    static constexpr bool PERM = true;
    const bf16_t* YG; bf16_t* SX; const float* bglu;
    __device__ __forceinline__ void operator()(const f32x4 (&acc)[2][2][4][2], const Unit& u, int wr, int wc, int fr, int fq) const {
        const int row0 = u.pm * 256 + wr * 64 + fr, col0 = u.pn * 256 + wc * 32 + 8 * fq;
#pragma unroll
        for (int bj = 0; bj < 2; ++bj) {
            const f32x4 bv0 = *(const f32x4*)(bglu + col0 + bj * 128), bv1 = *(const f32x4*)(bglu + col0 + bj * 128 + 4);
#pragma unroll
            for (int ai = 0; ai < 2; ++ai)
#pragma unroll
                for (int m = 0; m < 4; ++m) {
                    const size_t o = (size_t)(row0 + ai * 128 + m * 16) * 512 + col0 + bj * 128;
                    const u32x4 y = *(const u32x4*)(YG + o);
                    const f32x4 v0 = acc[ai][bj][m][0] + bv0, v1 = acc[ai][bj][m][1] + bv1;
                    u32x4 w;
                    w.x = pk2(bflo(y.x) * sigmoidf_(v0[0]), bfhi(y.x) * sigmoidf_(v0[1])); w.y = pk2(bflo(y.y) * sigmoidf_(v0[2]), bfhi(y.y) * sigmoidf_(v0[3]));
                    w.z = pk2(bflo(y.z) * sigmoidf_(v1[0]), bfhi(y.z) * sigmoidf_(v1[1])); w.w = pk2(bflo(y.w) * sigmoidf_(v1[2]), bfhi(y.w) * sigmoidf_(v1[3]));
                    *(u32x4*)(SX + o) = w;
                }
        }
    }
};

template <bool ACCUM> struct EpiMerge {
    static constexpr bool PERM = true;
    const bf16_t* Gt; bf16_t* Mb;
    __device__ __forceinline__ void operator()(const f32x4 (&acc)[2][2][4][2], const Unit& u, int wr, int wc, int fr, int fq) const {
        const int row0 = u.pm * 256 + wr * 64 + fr, col0 = u.pn * 256 + wc * 32 + 8 * fq;
#pragma unroll
        for (int ai = 0; ai < 2; ++ai)
#pragma unroll
            for (int m = 0; m < 4; ++m)
#pragma unroll
                for (int bj = 0; bj < 2; ++bj) {
                    const size_t o = (size_t)(row0 + ai * 128 + m * 16) * D + col0 + bj * 128;
                    const u32x4 gt = *(const u32x4*)(Gt + o);
                    const f32x4 v0 = acc[ai][bj][m][0], v1 = acc[ai][bj][m][1];
                    float r0 = bflo(gt.x) * v0[0], r1 = bfhi(gt.x) * v0[1], r2 = bflo(gt.y) * v0[2], r3 = bfhi(gt.y) * v0[3];
                    float r4 = bflo(gt.z) * v1[0], r5 = bfhi(gt.z) * v1[1], r6 = bflo(gt.w) * v1[2], r7 = bfhi(gt.w) * v1[3];
                    if (ACCUM) { const u32x4 p = *(const u32x4*)(Mb + o);
                        r0 += bflo(p.x); r1 += bfhi(p.x); r2 += bflo(p.y); r3 += bfhi(p.y); r4 += bflo(p.z); r5 += bfhi(p.z); r6 += bflo(p.w); r7 += bfhi(p.w); }
                    u32x4 w; w.x = pk2(r0, r1); w.y = pk2(r2, r3); w.z = pk2(r4, r5); w.w = pk2(r6, r7);
                    *(u32x4*)(Mb + o) = w;
                }
    }
};

__device__ __forceinline__ void tr_item(const float* W, int K, int N, int k0, int scol0, bf16_t* WT, int drow0, LAS float* scr, int lane) {
#pragma unroll 8
    for (int i = 0; i < 32; ++i) { const int kk = 2 * i + (lane >> 5); scr[kk * 33 + (lane & 31)] = W[(size_t)(k0 + kk) * N + scol0 + (lane & 31)]; }
    LDS_WAIT();
    const int c = lane & 7;
#pragma unroll
    for (int j = 0; j < 4; ++j) { const int n = (lane >> 3) + 8 * j; const LAS float* s = scr + (8 * c) * 33 + n;
        u32x4 o; o.x = pk2(s[0 * 33], s[1 * 33]); o.y = pk2(s[2 * 33], s[3 * 33]); o.z = pk2(s[4 * 33], s[5 * 33]); o.w = pk2(s[6 * 33], s[7 * 33]);
        *(u32x4*)(WT + (size_t)(drow0 + n) * K + k0 + 8 * c) = o; }
    LDS_WAIT();
}
__device__ __forceinline__ int src_w13(int n0) { const int pn = n0 >> 8, s = n0 & 255; return (s >> 7) * DFF + 128 * pn + (s & 127); }
__device__ __forceinline__ int src_winm(int n0) {
    if (n0 < 2048) { const int base = n0 < 1024 ? 0 : 1024, nn = n0 - base, pn = nn >> 8, s = nn & 255, bj = s >> 7, wc = (s & 127) >> 5, hcg = 4 * pn + wc; return base + hcg * 64 + 32 * bj; }
    if (n0 < 2560) return 3072 + (n0 - 2048);
    return 3584 + (n0 - 2560);
}

__global__ void __launch_bounds__(512, 2) mega(Args a) {
    extern __shared__ __attribute__((aligned(16))) unsigned char smem[];
    LAS unsigned char* lds = (LAS unsigned char*)smem;
    const int wave = __builtin_amdgcn_readfirstlane(threadIdx.x >> 6);
    const int G = gridDim.x, cb = blockIdx.x;
    const int gw = cb * 8 + wave, NW = G * 8;
    unsigned char* ws = a.ws;
    bf16_t* W13_1 = (bf16_t*)(ws + WS_W13_1); bf16_t* W2_1 = (bf16_t*)(ws + WS_W2_1); bf16_t* WINM = (bf16_t*)(ws + WS_WIN_M); bf16_t* WINV = (bf16_t*)(ws + WS_WIN_V);
    bf16_t* WGLU = (bf16_t*)(ws + WS_WGLU); bf16_t* WPA = (bf16_t*)(ws + WS_WPA); bf16_t* WPS = (bf16_t*)(ws + WS_WPS); bf16_t* WOUT = (bf16_t*)(ws + WS_WOUT);
    bf16_t* W13_2 = (bf16_t*)(ws + WS_W13_2); bf16_t* W2_2 = (bf16_t*)(ws + WS_W2_2);
    float* MOD = (float*)(ws + WS_MOD); float* ROPEC = (float*)(ws + WS_ROPE); float* ROPES = ROPEC + SEQ * 32;
    float* S5AR = (float*)(ws + WS_S5A); float* S5AI = S5AR + 2 * 32 * 64; bf16_t* SBB = (bf16_t*)(ws + WS_SBB); bf16_t* SCM = (bf16_t*)(ws + WS_SCM); float* LAMP = (float*)(ws + WS_LAM);
    float* X1 = (float*)(ws + WS_X1); bf16_t* HBUF = (bf16_t*)(ws + WS_HBUF); bf16_t* ACT = (bf16_t*)(ws + WS_ACT); bf16_t* VT = (bf16_t*)(ws + WS_VT);
    bf16_t* YB = (bf16_t*)(ws + WS_Y); bf16_t* QB = (bf16_t*)(ws + WS_QB); bf16_t* KB = (bf16_t*)(ws + WS_KB); bf16_t* UG = (bf16_t*)(ws + WS_UG);
    bf16_t* YG = (bf16_t*)(ws + WS_YG); bf16_t* SX = (bf16_t*)(ws + WS_SX); bf16_t* MBUF = (bf16_t*)(ws + WS_MBUF);
    bf16_t* GA = (bf16_t*)a.out; bf16_t* GS = GA + (size_t)TX * D;
    const float* Xin = a.in[0]; const float* Cin = a.in[2];

#ifndef PHMASK
#define PHMASK 0x7fff
#endif
#define PH(n) if (((PHMASK >> (n)) & 1) && a.ph_lo <= (n) && (n) < a.ph_hi)
#if MK_SPLIT
#define GSYNC(n) do { } while (0)
#else
#define GSYNC(n) do { if (a.ph_lo <= (n) && (n) + 1 < a.ph_hi) { bar_t += (unsigned)G; \
        asm volatile("s_waitcnt vmcnt(0) lgkmcnt(0)" ::: "memory");       \
        __syncthreads(); \
        if (wave == 0) {                                                   \
            __builtin_amdgcn_fence(__ATOMIC_RELEASE, "agent"); asm volatile("s_waitcnt vmcnt(0)" ::: "memory"); \
            if (lane_id() == 0) { __hip_atomic_fetch_add(BARW, 1u, __ATOMIC_RELAXED, __HIP_MEMORY_SCOPE_AGENT); \
                while (__hip_atomic_load(BARW, __ATOMIC_RELAXED, __HIP_MEMORY_SCOPE_AGENT) < bar_t) __builtin_amdgcn_s_sleep(1); } \
            __builtin_amdgcn_fence(__ATOMIC_ACQUIRE, "agent"); asm volatile("s_waitcnt vmcnt(0) lgkmcnt(0)" ::: "memory"); } \
        __syncthreads(); } } while (0)
#endif
    unsigned* BARW = (unsigned*)(ws + WS_BAR); unsigned bar_t = 0;
#if !MK_SPLIT
    if (a.ph_lo == 0) cg::this_grid().sync();
#endif

    PH(0) {
        const int lane = opq(lane_id()), tid = wave * 64 + lane;
        for (int slab = cb; slab < NMODC / 64; slab += G) {
            LAS float* sl = (LAS float*)lds;
            LAS float* red = (LAS float*)(lds + 17 * 1024 * 4);
            for (int i = tid; i < 17 * 1024; i += 512) { const int mb = i >> 10, k = i & 1023; const float v = mb < 16 ? a.in[1][mb * 1024 + k] : a.in[3][k]; sl[i] = siluf_(v); }
            __syncthreads();
            float accm[17];
#pragma unroll
            for (int j = 0; j < 17; ++j) accm[j] = 0.f;
            const float* wp = a.in[4] + (size_t)(wave * 128) * NMODC + slab * 64 + lane;
#pragma unroll 4
            for (int k = 0; k < 128; ++k) { const float w = wp[(size_t)k * NMODC];
#pragma unroll
                for (int j = 0; j < 17; ++j) accm[j] += w * sl[j * 1024 + wave * 128 + k]; }
#pragma unroll
            for (int j = 0; j < 17; ++j) red[(wave * 17 + j) * 64 + lane] = accm[j];
            __syncthreads();
            for (int i = tid; i < 17 * 64; i += 512) { const int j = i >> 6, l = i & 63; float s = a.in[5][slab * 64 + l];
#pragma unroll
                for (int w = 0; w < 8; ++w) s += red[(w * 17 + j) * 64 + l];
                MOD[(size_t)j * NMODC + slab * 64 + l] = s; }
            __syncthreads();
        }
        {
            LAS float* scr = (LAS float*)(lds + wave * 16384);
            constexpr int I13 = 16 * 176, I2 = 44 * 32, IINM = 16 * 144, IINV = 16 * 32, IGLU = 8 * 16, IPA = 16 * 32, IPS = 8 * 32, IOUT = 16 * 32;
            constexpr int NIT = 2 * I13 + 2 * I2 + IINM + IINV + IGLU + IPA + IPS + IOUT;
            for (int it = gw; it < NIT; it += NW) {
                int r = it;
                if (r < I13) { const int kb = r / 176, nb = r % 176; tr_item(a.in[7], D, 2 * DFF, 64 * kb, src_w13(32 * nb), W13_1, 32 * nb, scr, lane); continue; } r -= I13;
                if (r < I13) { const int kb = r / 176, nb = r % 176; tr_item(a.in[32], D, 2 * DFF, 64 * kb, src_w13(32 * nb), W13_2, 32 * nb, scr, lane); continue; } r -= I13;
                if (r < I2) { const int kb = r / 32, nb = r % 32; tr_item(a.in[8], DFF, D, 64 * kb, 32 * nb, W2_1, 32 * nb, scr, lane); continue; } r -= I2;
                if (r < I2) { const int kb = r / 32, nb = r % 32; tr_item(a.in[33], DFF, D, 64 * kb, 32 * nb, W2_2, 32 * nb, scr, lane); continue; } r -= I2;
                if (r < IINM) { const int kb = r / 144, nb = r % 144; tr_item(a.in[10], D, 5632, 64 * kb, src_winm(32 * nb), WINM, 32 * nb, scr, lane); continue; } r -= IINM;
                if (r < IINV) { const int kb = r / 32, nb = r % 32; tr_item(a.in[10], D, 5632, 64 * kb, 2048 + 32 * nb, WINV, 32 * nb, scr, lane); continue; } r -= IINV;
                if (r < IGLU) { const int kb = r / 16, nb = r % 16; tr_item(a.in[26], 512, 512, 64 * kb, 32 * nb, WGLU, 32 * nb, scr, lane); continue; } r -= IGLU;
                if (r < IPA) { const int kb = r / 32, nb = r % 32; tr_item(a.in[28], D, D, 64 * kb, 32 * nb, WPA, 32 * nb, scr, lane); continue; } r -= IPA;
                if (r < IPS) { const int kb = r / 32, nb = r % 32; tr_item(a.in[29], 512, D, 64 * kb, 32 * nb, WPS, 32 * nb, scr, lane); continue; } r -= IPS;
                { const int kb = r / 32, nb = r % 32; tr_item(a.in[30], D, D, 64 * kb, 32 * nb, WOUT, 32 * nb, scr, lane); }
            }
        }
        for (int i = cb * 512 + tid; i < SEQ * 32; i += G * 512) {
            const int t = i >> 5, f = i & 31; const int pos = f < 16 ? (t >> 6) : (t & 63); const int fi = f & 15;
            const float inv = (float)pow(10000.0, -(double)fi / 16.0); const float ang = (float)pos * inv;
            ROPEC[i] = (float)cos((double)ang); ROPES[i] = (float)sin((double)ang);
        }
        for (int i = cb * 512 + tid; i < 2 * 32 * 64; i += G * 512) {
            const int dg = i >> 6, p = i & 63;
            const double lre = a.in[18][i], lim = a.in[19][i], dt = exp((double)a.in[20][dg]);
            const double mag = exp(lre * dt), ar = mag * cos(lim * dt), ai = mag * sin(lim * dt), den = lre * lre + lim * lim, nr = ar - 1.0;
            const double fr_ = (nr * lre + ai * lim) / den, fi_ = (ai * lre - nr * lim) / den;
            S5AR[i] = (float)ar; S5AI[i] = (float)ai;
            const float* bre = a.in[21] + (size_t)i * 16; const float* bim = a.in[22] + (size_t)i * 16;
#pragma unroll
            for (int c2 = 0; c2 < 16; c2 += 2) {
                const double r0 = fr_ * bre[c2] - fi_ * bim[c2], r1 = fr_ * bre[c2 + 1] - fi_ * bim[c2 + 1], i0 = fr_ * bim[c2] + fi_ * bre[c2], i1 = fr_ * bim[c2 + 1] + fi_ * bre[c2 + 1];
                *(unsigned*)(SBB + ((size_t)dg * 128 + 64 * (p >> 5) + (p & 31)) * 16 + c2) = pk2((float)r0, (float)r1);
                *(unsigned*)(SBB + ((size_t)dg * 128 + 64 * (p >> 5) + 32 + (p & 31)) * 16 + c2) = pk2((float)i0, (float)i1);
            }
        }
        for (int i = cb * 512 + tid; i < 2 * 32 * 16 * 64; i += G * 512) {
            const int p2 = (i & 31) * 2, dgc = i >> 5;
            if (i < 2 * 32 * 16 * 32) {
                const float* cre = a.in[23] + (size_t)dgc * 64; const float* cim = a.in[24] + (size_t)dgc * 64;
                *(unsigned*)(SCM + (size_t)dgc * 128 + 2 * p2) = pk2(cre[p2], -cim[p2]);
                *(unsigned*)(SCM + (size_t)dgc * 128 + 2 * p2 + 2) = pk2(cre[p2 + 1], -cim[p2 + 1]);
            }
        }
        if (cb == 0 && tid == 0) {
            float s1 = 0.f, s2 = 0.f;
            for (int i = 0; i < 64; ++i) { s1 += a.in[13][i] * a.in[14][i]; s2 += a.in[15][i] * a.in[16][i]; }
            LAMP[0] = expf(s1) - expf(s2) + 0.2f;
            float gq = 0.f, gk = 0.f;
            for (int i = 0; i < 64; ++i) { gq = fmaxf(gq, fabsf(a.in[11][i])); gk = fmaxf(gk, fabsf(a.in[12][i])); }
            LAMP[1] = 1.02f * 64.f * gq * gk * QSCALE;
        }
    }
    GSYNC(0);

    auto norm_phase = [&](const float* srcX, const float* srcC, int nrows, const float* gain, int sh_chunk, int sc_chunk) {
        const int nchunk = nrows / 8; const int lane = opq(lane_id());
        for (int ch = gw; ch < nchunk; ch += NW) {
            const int r0 = ch * 8; const int mb = r0 < TX ? (r0 >> 12) : 16;
            f32x4 ga[4], sh[4];
#pragma unroll
            for (int j = 0; j < 4; ++j) { const int c = 4 * lane + 256 * j;
                const f32x4 g4 = *(const f32x4*)(gain + c), sc4 = *(const f32x4*)(MOD + (size_t)mb * NMODC + sc_chunk * D + c);
                ga[j] = g4 * (sc4 + 1.0f); sh[j] = *(const f32x4*)(MOD + (size_t)mb * NMODC + sh_chunk * D + c); }
            for (int rr = 0; rr < 8; ++rr) {
                const int r = r0 + rr;
                const float* xr = r < TX ? srcX + (size_t)r * D : srcC + (size_t)(r - TX) * D;
                f32x4 v[4]; float s = 0.f;
#pragma unroll
                for (int j = 0; j < 4; ++j) { v[j] = *(const f32x4*)(xr + 4 * lane + 256 * j); s += (v[j][0] * v[j][0] + v[j][1] * v[j][1]) + (v[j][2] * v[j][2] + v[j][3] * v[j][3]); }
                const float rstd = rsqrtf(wave_sum(s) * (1.f / D) + EPS);
#pragma unroll
                for (int j = 0; j < 4; ++j) { const f32x4 y = v[j] * rstd * ga[j] + sh[j]; u32x2 w; w.x = pk2(y[0], y[1]); w.y = pk2(y[2], y[3]);
                    *(u32x2*)(HBUF + (size_t)r * D + 4 * lane + 256 * j) = w; }
            }
        }
    };

    PH(1) { norm_phase(Xin, Cin, TT, a.in[6], 0, 1); }
    GSYNC(1);
#ifndef REPG
#define REPG 1
#endif
#pragma unroll 1
    for (int rg = 0; rg < REPG; ++rg)
    PH(2) { pg8::SegOrder S; S.init(272, 22, 0, 0, 0, 1, G, cb); pg8::Gemm g{HBUF, W13_1, D}; EpiSwiglu E{ACT}; pg8::gemm_phase<EpiSwiglu, false>(lds, g, S, E, wave); }
    GSYNC(2);
#pragma unroll 1
    for (int rg = 0; rg < REPG; ++rg)
    PH(3) { pg8::SegOrder S; S.init(272, 4, 0, 0, 0, 1, G, cb); pg8::Gemm g{ACT, W2_1, DFF}; EpiResid E{Xin, Cin, X1, MOD + 2 * D, 0.5f}; pg8::gemm_phase<EpiResid, false>(lds, g, S, E, wave); }
    GSYNC(3);
#ifndef REP56
#define REP56 1
#endif
#pragma unroll 1
    for (int rep56 = 0; rep56 < REP56; ++rep56) {
    PH(4) { norm_phase(X1, X1 + (size_t)TX * D, TT, a.in[9], 3, 4); }
    GSYNC(4);
#ifndef REP5
#define REP5 1
#endif
#pragma unroll 1
    for (int r5 = 0; r5 < REP5; ++r5)
    PH(5) {
        { pg8::SegOrder S; S.init(256, 18, 256, 16, 4, 6, G, cb); pg8::Gemm g{HBUF, WINM, D}; EpiInMain E{QB, KB, UG, GA, GS, a.in[11], a.in[12], ROPEC, ROPES}; pg8::gemm_phase<EpiInMain, false>(lds, g, S, E, wave); }
        { pg8::SegOrder S; S.init(272, 4, 0, 0, 0, 1, G, (cb + G / 2) % G);
          pg8::Gemm g{HBUF, WINV, D}; EpiInV E{VT}; pg8::gemm_phase<EpiInV, true>(lds, g, S, E, wave); }
    }
    GSYNC(5);

    PH(6) {
        const int lane = opq(lane_id()), tid = wave * 64 + lane;
        const int hh = lane >> 5, l31 = lane & 31;
#ifndef REPS
#define REPS 1
#endif
#pragma unroll 1
        for (int rs = 0; rs < REPS; ++rs)
        for (int si = cb; si < 256; si += G) if (wave < 4) {
            const int task = si * 4 + wave, b = task >> 6, d = (task >> 5) & 1, g = task & 31, dg = d * 32 + g;
            LAS unsigned char* wl = lds + wave * 16896;
            const float ar = S5AR[dg * 64 + lane], ai = S5AI[dg * 64 + lane];
            bf16x8 bfr[4], cfr[4];
#pragma unroll
            for (int nt = 0; nt < 4; ++nt) bfr[nt] = *(const bf16x8*)(SBB + ((size_t)dg * 128 + l31 + 32 * nt) * 16 + 8 * hh);
#pragma unroll
            for (int kk = 0; kk < 4; ++kk) cfr[kk] = *(const bf16x8*)(SCM + ((size_t)dg * 16 + (lane & 15)) * 128 + 32 * kk + 8 * (lane >> 4));
            const bf16_t* ug = UG + (size_t)(b * 32 + g) * LK * 16;
            bf16_t* yo = YB + ((size_t)d * TX + (size_t)b * SEQ) * 512 + g * 16;
            float hr = 0.f, hi = 0.f;
            auto upos = [&](int ch) { const int s = 32 * ch + l31; return d == 0 ? s : (s < LC ? LC - 1 - s : LK + LC - 1 - s); };
            bf16x8 afn = *(const bf16x8*)(ug + (size_t)upos(0) * 16 + 8 * hh);
            for (int ch = 0; ch < LK / 32; ++ch) {
                const bf16x8 af = afn;
                if (ch + 1 < LK / 32) afn = *(const bf16x8*)(ug + (size_t)upos(ch + 1) * 16 + 8 * hh);
                f32x16 bu[4];
#pragma unroll
                for (int nt = 0; nt < 4; ++nt) { f32x16 z;
#pragma unroll
                    for (int q = 0; q < 16; ++q) z[q] = 0.f;
                    bu[nt] = __builtin_amdgcn_mfma_f32_32x32x16_bf16(af, bfr[nt], z, 0, 0, 0); }
                float reA[16], reB[16], imA[16], imB[16];
#pragma unroll
                for (int r = 0; r < 16; ++r) {
                    const auto sr = __builtin_amdgcn_permlane32_swap(__float_as_uint(bu[0][r]), __float_as_uint(bu[2][r]), false, false);
                    const auto si_ = __builtin_amdgcn_permlane32_swap(__float_as_uint(bu[1][r]), __float_as_uint(bu[3][r]), false, false);
                    reA[r] = __uint_as_float(sr[0]); reB[r] = __uint_as_float(sr[1]); imA[r] = __uint_as_float(si_[0]); imB[r] = __uint_as_float(si_[1]);
                }
#pragma unroll
                for (int i = 0; i < 4; ++i) {
#pragma unroll
                    for (int j = 0; j < 4; ++j) { const int t = 8 * i + j;
                        const float nhr = fmaf(-ai, hi, fmaf(ar, hr, reA[4 * i + j])), nhi = fmaf(ai, hr, fmaf(ar, hi, imA[4 * i + j]));
                        hr = nhr; hi = nhi; *(LAS unsigned*)(wl + t * 528 + lane * 4) = pk2(hr, hi); }
#pragma unroll
                    for (int j = 0; j < 4; ++j) { const int t = 8 * i + 4 + j;
                        const float nhr = fmaf(-ai, hi, fmaf(ar, hr, reB[4 * i + j])), nhi = fmaf(ai, hr, fmaf(ar, hi, imB[4 * i + j]));
                        hr = nhr; hi = nhi; *(LAS unsigned*)(wl + t * 528 + lane * 4) = pk2(hr, hi); }
                }
                CFENCE();
                if (ch >= LC / 32) {
#pragma unroll
                    for (int mt = 0; mt < 2; ++mt) {
                        f32x4 y = (f32x4){0.f, 0.f, 0.f, 0.f};
#pragma unroll
                        for (int kk = 0; kk < 4; ++kk) { const bf16x8 hf = *(const LAS bf16x8*)(wl + (16 * mt + (lane & 15)) * 528 + (32 * kk + 8 * (lane >> 4)) * 2);
                            y = __builtin_amdgcn_mfma_f32_16x16x32_bf16(cfr[kk], hf, y, 0, 0, 0); }
                        const int s2 = 32 * ch + 16 * mt + (lane & 15);
                        const int tok = d == 0 ? s2 - LC : (LK - 1 - s2);
                        u32x2 w; w.x = pk2(y[0], y[1]); w.y = pk2(y[2], y[3]);
                        *(u32x2*)(yo + (size_t)tok * 512 + 4 * (lane >> 4)) = w;
                    }
                }
                CFENCE();
            }
        }
        __syncthreads();
        const float negC = __builtin_amdgcn_readfirstlane(__float_as_int(LAMP[1] > 64.f ? -LAMP[1] : 0.f)) == 0 ? 0.f : -LAMP[1];
        LAS unsigned* stab = (LAS unsigned*)(lds + 145408 + wave * 1536);
        {
            const int lane = opq(lane_id());
#pragma unroll
            for (int i = 0; i < 3; ++i) { const int slot = 64 * (wave + 8 * i) + lane; int key = slot / 17, c = slot % 17; if (c == 16) c = 0; if (key > 63) key = 63; stab[i * 64 + lane] = (unsigned)(key * 256 + c * 16);
                int dv = slot / 9, c2 = slot % 9; if (c2 == 8) c2 = 0; if (dv > 127) dv = 127; stab[(3 + i) * 64 + lane] = (unsigned)(dv * 128 + c2 * 16); }
        }
            constexpr int KBUF = 17408, VBUF = 18432, VOFF = 2 * KBUF;
#define ATT_STAGE(buf, tile) do { _Pragma("unroll") for (int _i = 0; _i < 3; ++_i) { const int _j = wave + 8 * _i; \
                if (_j < 17) __builtin_amdgcn_global_load_lds((const unsigned*)((const char*)Kg + (size_t)(tile) * 16384 + stab[_i * 64 + lane]), (LAS unsigned*)(lds + (buf) * KBUF + _j * 1024), 16, 0, 0); \
                if (_j < 18) __builtin_amdgcn_global_load_lds((const unsigned*)((const char*)Vg + (size_t)(tile) * 16384 + stab[(3 + _i) * 64 + lane]), (LAS unsigned*)(lds + VOFF + (buf) * VBUF + _j * 1024), 16, 0, 0); } } while (0)
#ifndef REPA
#define REPA 1
#endif
#pragma unroll 1
        for (int repa = 0; repa < REPA; ++repa)
        for (int ai_ = cb; ai_ < NB * NH * 16 * DBG_ATT; ai_ += G) {
            const int lane = opq(lane_id()), hh = lane >> 5, l31 = lane & 31;
            const int cp = ai_ & 255, jr = ai_ >> 8;
            const int bh = 16 * jr + 2 * (cp & 7) + ((cp >> 3) >> 4), qt = (cp >> 3) & 15;
            const int b = bh >> 3, h = bh & 7;
            const int comp = wave >> 2, rg = wave & 3;
            const size_t row0 = (size_t)b * SEQ + qt * 256 + rg * 64;
            const bf16_t* Kg = KB + (size_t)bh * LK * 128; const bf16_t* Vg = VT + (size_t)bh * NKT * 8192;
            ATT_STAGE(0, 0);
            LAS unsigned char* qb_ = lds + 71680 + wave * 9216;
            {
                u32x4 qr[8];
#pragma unroll
                for (int j = 0; j < 8; ++j) { const int q = 8 * j + (lane >> 3), c = lane & 7; qr[j] = *(const u32x4*)(QB + (row0 + q) * D + h * 128 + comp * 64 + c * 8); }
#pragma unroll
                for (int j = 0; j < 8; ++j) { const int q = 8 * j + (lane >> 3), c = lane & 7; *(LAS u32x4*)(qb_ + q * 144 + c * 16) = qr[j]; }
            }
            f32x16 O[2][4];
#pragma unroll
            for (int qs = 0; qs < 2; ++qs)
#pragma unroll
                for (int mt = 0; mt < 4; ++mt)
#pragma unroll
                    for (int q = 0; q < 16; ++q) O[qs][mt][q] = 0.f;
            float lsum[2] = {0.f, 0.f};
#define SOFTMAX_STEP(S, L, P) do { \
            float ps = 0.f; unsigned pw[8]; \
            if (negC != 0.f) { _Pragma("unroll") for (int q = 0; q < 16; ++q) S[q] += negC; } \
            _Pragma("unroll") for (int q = 0; q < 16; q += 2) { const float e0 = fexp2(S[q]), e1 = fexp2(S[q + 1]); ps += e0 + e1; pw[q >> 1] = pk2(e0, e1); } \
            L += ps; \
            { u32x4 t0 = (u32x4){pw[0], pw[1], pw[2], pw[3]}, t1 = (u32x4){pw[4], pw[5], pw[6], pw[7]}; P[0] = __builtin_bit_cast(bf16x8, t0); P[1] = __builtin_bit_cast(bf16x8, t1); } } while (0)
#define ATT_BAR() do { asm volatile("s_waitcnt lgkmcnt(0)" ::: "memory"); __builtin_amdgcn_s_barrier(); asm volatile("" ::: "memory"); } while (0)
            asm volatile("s_waitcnt vmcnt(0)" ::: "memory");
            __syncthreads();
            for (int it = 0; it < NKT; ++it) {
                const int cur = it & 1;
                LAS unsigned char* kb_ = lds + cur * KBUF + l31 * 272 + hh * 16 + comp * 128; LAS unsigned char* vb_ = lds + VOFF + cur * VBUF + l31 * 144 + hh * 16;
                LAS unsigned char* qa_ = qb_ + l31 * 144 + hh * 16;
                f32x16 sA0, sA1, sB0, sB1;
#pragma unroll
                for (int q = 0; q < 16; ++q) { sA0[q] = 0.f; sA1[q] = 0.f; sB0[q] = 0.f; sB1[q] = 0.f; }
#pragma unroll
                for (int kk = 0; kk < 4; ++kk) {
                    const bf16x8 kf = *(const LAS bf16x8*)(kb_ + kk * 32);
                    const bf16x8 q0 = *(const LAS bf16x8*)(qa_ + kk * 32), q1 = *(const LAS bf16x8*)(qa_ + 32 * 144 + kk * 32);
                    sA0 = __builtin_amdgcn_mfma_f32_32x32x16_bf16(kf, q0, sA0, 0, 0, 0);
                    sA1 = __builtin_amdgcn_mfma_f32_32x32x16_bf16(kf, q1, sA1, 0, 0, 0);
                }
#pragma unroll
                for (int kk = 0; kk < 4; ++kk) {
                    const bf16x8 kf = *(const LAS bf16x8*)(kb_ + 32 * 272 + kk * 32);
                    const bf16x8 q0 = *(const LAS bf16x8*)(qa_ + kk * 32), q1 = *(const LAS bf16x8*)(qa_ + 32 * 144 + kk * 32);
                    sB0 = __builtin_amdgcn_mfma_f32_32x32x16_bf16(kf, q0, sB0, 0, 0, 0);
                    sB1 = __builtin_amdgcn_mfma_f32_32x32x16_bf16(kf, q1, sB1, 0, 0, 0);
                }
                bf16x8 pA[2][2], pB[2][2];
                SOFTMAX_STEP(sA0, lsum[0], pA[0]);
                SOFTMAX_STEP(sA1, lsum[1], pA[1]);
#pragma unroll
                for (int s = 0; s < 2; ++s) {
                    if (s == 1 && it + 1 < NKT) ATT_STAGE(cur ^ 1, it + 1);
#pragma unroll
                    for (int mt = 0; mt < 4; ++mt) {
                        const bf16x8 vf = *(const LAS bf16x8*)(vb_ + mt * (32 * 144) + (2 * s) * 16);
                        O[0][mt] = __builtin_amdgcn_mfma_f32_32x32x16_bf16(vf, pA[0][s], O[0][mt], 0, 0, 0);
                        O[1][mt] = __builtin_amdgcn_mfma_f32_32x32x16_bf16(vf, pA[1][s], O[1][mt], 0, 0, 0);
                    }
                }
                SOFTMAX_STEP(sB0, lsum[0], pB[0]);
                SOFTMAX_STEP(sB1, lsum[1], pB[1]);
#pragma unroll
                for (int s = 0; s < 2; ++s)
#pragma unroll
                    for (int mt = 0; mt < 4; ++mt) {
                        const bf16x8 vf = *(const LAS bf16x8*)(vb_ + mt * (32 * 144) + (4 + 2 * s) * 16);
                        O[0][mt] = __builtin_amdgcn_mfma_f32_32x32x16_bf16(vf, pB[0][s], O[0][mt], 0, 0, 0);
                        O[1][mt] = __builtin_amdgcn_mfma_f32_32x32x16_bf16(vf, pB[1][s], O[1][mt], 0, 0, 0);
                    }
                asm volatile("s_waitcnt vmcnt(0)" ::: "memory"); ATT_BAR();
            }
            const int lane2 = opq(lane_id()), hh2 = lane2 >> 5, l31b = lane2 & 31;
            lsum[0] += __shfl_xor(lsum[0], 32); lsum[1] += __shfl_xor(lsum[1], 32);
            LAS float* xb = (LAS float*)(lds + rg * 32768) + lane2;
            if (comp == 1) {
                const float lam = LAMP[0];
#pragma unroll
                for (int qs = 0; qs < 2; ++qs) { const float sc = lam * frcp(lsum[qs]);
#pragma unroll
                    for (int mt = 0; mt < 4; ++mt)
#pragma unroll
                        for (int q = 0; q < 16; ++q) xb[((qs * 4 + mt) * 16 + q) * 64] = O[qs][mt][q] * sc; }
            }
            __syncthreads();
            if (comp == 0) {
#pragma unroll
                for (int qs = 0; qs < 2; ++qs) {
                    const float i0 = frcp(lsum[qs]); float ss = 0.f;
#pragma unroll
                    for (int mt = 0; mt < 4; ++mt)
#pragma unroll
                        for (int q = 0; q < 16; ++q) { const float o = O[qs][mt][q] * i0 - xb[((qs * 4 + mt) * 16 + q) * 64]; O[qs][mt][q] = o; ss += o * o; }
                    ss += __shfl_xor(ss, 32);
                    const float rstd = rsqrtf(ss * (1.f / 128.f) + EPS) * 0.8f;
                    bf16_t* op = QB + (row0 + 32 * qs + l31b) * D + h * 128 + 4 * hh2;
#pragma unroll
                    for (int mt = 0; mt < 4; ++mt)
#pragma unroll
                        for (int q4 = 0; q4 < 4; ++q4) {
                            const f32x4 sg = *(const f32x4*)(a.in[17] + 32 * mt + 8 * q4 + 4 * hh2);
                            u32x2 w; w.x = pk2(O[qs][mt][4 * q4] * rstd * sg[0], O[qs][mt][4 * q4 + 1] * rstd * sg[1]); w.y = pk2(O[qs][mt][4 * q4 + 2] * rstd * sg[2], O[qs][mt][4 * q4 + 3] * rstd * sg[3]);
                            *(u32x2*)(op + 32 * mt + 8 * q4) = w;
                        }
                }
            }
            __syncthreads();
        }
    }
    GSYNC(6);
    }

#define BSYNC() do { asm volatile("s_waitcnt vmcnt(0) lgkmcnt(0)" ::: "memory"); __syncthreads(); \
        if (wave == 0) { __builtin_amdgcn_fence(__ATOMIC_ACQUIRE, "agent"); asm volatile("s_waitcnt vmcnt(0) lgkmcnt(0)" ::: "memory"); } __syncthreads(); } while (0)
    PH(7) {
        for (int pm = cb; pm < TX / 256; pm += G) {
            {
                const int tid = wave * 64 + opq(lane_id());
                for (int i = tid; i < 256 * 64; i += 512) {
                    const size_t tok = (size_t)pm * 256 + (i >> 6); const int j = i & 63, ch0 = 8 * j, g = j >> 1, c0 = 8 * (j & 1);
                    const int b = (int)(tok >> 12), t = (int)(tok & (SEQ - 1));
                    const u32x4 y0 = *(const u32x4*)(YB + tok * 512 + ch0), y1 = *(const u32x4*)(YB + ((size_t)TX + tok) * 512 + ch0);
                    const u32x4 uu = *(const u32x4*)(UG + ((size_t)(b * 32 + g) * LK + LC + t) * 16 + c0);
                    const f32x4 d0 = *(const f32x4*)(a.in[25] + ch0), d1 = *(const f32x4*)(a.in[25] + ch0 + 4);
                    u32x4 w;
                    w.x = pk2(gelu_tanh(bflo(y0.x) + bflo(y1.x) + d0[0] * bflo(uu.x)), gelu_tanh(bfhi(y0.x) + bfhi(y1.x) + d0[1] * bfhi(uu.x)));
                    w.y = pk2(gelu_tanh(bflo(y0.y) + bflo(y1.y) + d0[2] * bflo(uu.y)), gelu_tanh(bfhi(y0.y) + bfhi(y1.y) + d0[3] * bfhi(uu.y)));
                    w.z = pk2(gelu_tanh(bflo(y0.z) + bflo(y1.z) + d1[0] * bflo(uu.z)), gelu_tanh(bfhi(y0.z) + bfhi(y1.z) + d1[1] * bfhi(uu.z)));
                    w.w = pk2(gelu_tanh(bflo(y0.w) + bflo(y1.w) + d1[2] * bflo(uu.w)), gelu_tanh(bfhi(y0.w) + bfhi(y1.w) + d1[3] * bfhi(uu.w)));
                    *(u32x4*)(YG + tok * 512 + ch0) = w;
                }
            }
            BSYNC();
            { pg8::SegOrder S; S.init(0, 1, pm, 1, 0, 2, 1, 0); pg8::Gemm g{YG, WGLU, 512}; EpiGlu E{YG, SX, a.in[27]}; pg8::gemm_phase<EpiGlu, false>(lds, g, S, E, wave); }
            BSYNC();
            { pg8::SegOrder S; S.init(0, 1, pm, 1, 0, 4, 1, 0); pg8::Gemm g{SX, WPS, 512}; EpiMerge<false> E{GS, MBUF}; pg8::gemm_phase<EpiMerge<false>, false>(lds, g, S, E, wave); }
            BSYNC();
            { pg8::SegOrder S; S.init(0, 1, pm, 1, 0, 4, 1, 0); pg8::Gemm g{QB, WPA, D}; EpiMerge<true> E{GA, MBUF}; pg8::gemm_phase<EpiMerge<true>, false>(lds, g, S, E, wave); }
            BSYNC();
            { pg8::SegOrder S; S.init(0, 1, pm, 1, 0, 4, 1, 0); pg8::Gemm g{MBUF, WOUT, D}; EpiResid E{X1, X1, X1, MOD + 5 * D, 1.0f}; pg8::gemm_phase<EpiResid, false>(lds, g, S, E, wave); }
            BSYNC();
            {
                const int lane = opq(lane_id()); const int mb = pm >> 4;
                f32x4 ga[4], sh[4];
#pragma unroll
                for (int j = 0; j < 4; ++j) { const int c = 4 * lane + 256 * j;
                    const f32x4 g4 = *(const f32x4*)(a.in[31] + c), sc4 = *(const f32x4*)(MOD + (size_t)mb * NMODC + 7 * D + c);
                    ga[j] = g4 * (sc4 + 1.0f); sh[j] = *(const f32x4*)(MOD + (size_t)mb * NMODC + 6 * D + c); }
                for (int rr = wave; rr < 256; rr += 8) {
                    const size_t r = (size_t)pm * 256 + rr;
                    const float* xr = X1 + r * D;
                    f32x4 v[4]; float s2 = 0.f;
#pragma unroll
                    for (int j = 0; j < 4; ++j) { v[j] = *(const f32x4*)(xr + 4 * lane + 256 * j); s2 += (v[j][0] * v[j][0] + v[j][1] * v[j][1]) + (v[j][2] * v[j][2] + v[j][3] * v[j][3]); }
                    const float rstd = rsqrtf(wave_sum(s2) * (1.f / D) + EPS);
#pragma unroll
                    for (int j = 0; j < 4; ++j) { const f32x4 y = v[j] * rstd * ga[j] + sh[j]; u32x2 w; w.x = pk2(y[0], y[1]); w.y = pk2(y[2], y[3]);
                        *(u32x2*)(GA + r * D + 4 * lane + 256 * j) = w; }
                }
            }
            if (pm + G < TX / 256) BSYNC();
        }
    }
    GSYNC(7);
#pragma unroll 1
    for (int rg = 0; rg < REPG; ++rg)
    PH(13) { pg8::SegOrder S; S.init(256, 22, 0, 0, 0, 1, G, cb); pg8::Gemm g{GA, W13_2, D}; EpiSwiglu E{ACT}; pg8::gemm_phase<EpiSwiglu, false>(lds, g, S, E, wave); }
    GSYNC(13);
    PH(14) { pg8::SegOrder S; S.init(256, 4, 0, 0, 0, 1, G, cb); pg8::Gemm g{ACT, W2_2, DFF}; EpiResid E{X1, X1, a.out, MOD + 8 * D, 0.5f}; pg8::gemm_phase<EpiResid, false>(lds, g, S, E, wave); }
}

extern "C" void kernel_launch(void* const* d_in, const int* in_sizes, int n_in, void* d_out, int out_size, void* d_ws, size_t ws_size, hipStream_t stream) {
    static int grid = 0;
    if (grid == 0) {
        if (n_in != 34 || out_size != TX * D || ws_size < WS_END) { fprintf(stderr, "kernel_launch: unexpected shapes (n_in %d, out %d, ws %zu < %zu)\n", n_in, out_size, ws_size, (size_t)WS_END); grid = -1; return; }
        int dev = 0, cus = 0, per_cu = 0;
        hipGetDevice(&dev); hipDeviceGetAttribute(&cus, hipDeviceAttributeMultiprocessorCount, dev);
        if (hipFuncSetAttribute((const void*)mega, hipFuncAttributeMaxDynamicSharedMemorySize, LDS_BYTES) != hipSuccess) { fprintf(stderr, "kernel_launch: hipFuncSetAttribute failed\n"); grid = -1; return; }
        if (hipOccupancyMaxActiveBlocksPerMultiprocessor(&per_cu, (const void*)mega, 512, LDS_BYTES) != hipSuccess || per_cu < 1) { fprintf(stderr, "kernel_launch: occupancy query says %d\n", per_cu); per_cu = 1; }
        (void)hipGetLastError();
        grid = cus;
    }
    if (grid < 0) return;
    Args a{};
    for (int i = 0; i < 34; ++i) a.in[i] = (const float*)d_in[i];
    a.out = (float*)d_out; a.ws = (unsigned char*)d_ws;
#if MK_SPLIT
    for (int p = 0; p < NPHASE; ++p) { a.ph_lo = p; a.ph_hi = p + 1; hipLaunchKernelGGL(mega, dim3(grid), dim3(512), LDS_BYTES, stream, a); }
#else
    a.ph_lo = 0; a.ph_hi = NPHASE;
    if (hipMemsetAsync((unsigned char*)d_ws + WS_BAR, 0, 256, stream) != hipSuccess) { fprintf(stderr, "kernel_launch: memset of the barrier word failed\n"); return; }
    void* args[] = {&a};
    hipError_t e = hipLaunchCooperativeKernel((const void*)mega, dim3(grid), dim3(512), args, LDS_BYTES, stream);
    if (e != hipSuccess) fprintf(stderr, "cooperative launch failed: %s (grid %d)\n", hipGetErrorString(e), grid);
#endif
}
```

```cpp
#include <hip/hip_runtime.h>
#include <hip/hip_cooperative_groups.h>
#include <cstdio>
#include <cstdint>
namespace cg = cooperative_groups;

#define LAS __attribute__((address_space(3)))
typedef unsigned short bf16_t;
typedef short bf16x8 __attribute__((ext_vector_type(8)));
typedef float f32x4 __attribute__((ext_vector_type(4)));
typedef float f32x16 __attribute__((ext_vector_type(16)));
typedef unsigned u32x4 __attribute__((ext_vector_type(4)));
typedef unsigned u32x2 __attribute__((ext_vector_type(2)));

#define DBG_ATT 1
#define REPG 1
#define REP5 1
#ifndef MK_SPLIT
#define MK_SPLIT 0
#endif

constexpr int D = 1024, NB = 16, SEQ = 4096, LC = 256, LK = SEQ + LC, TX = NB * SEQ, TC = NB * LC, TT = TX + TC;
constexpr int NH = 8, DFF = 2816, NMODC = 9 * D, NKT = LK / 64;
constexpr int NPHASE = 15;
constexpr float EPS = 1e-6f;
constexpr float QSCALE = 0.125f * 1.4426950408889634f;

constexpr size_t al256(size_t x) { return (x + 255) & ~(size_t)255; }
constexpr size_t WS_W13_1 = 0;
constexpr size_t WS_W2_1 = WS_W13_1 + (size_t)2 * DFF * D * 2;
constexpr size_t WS_WIN_M = WS_W2_1 + (size_t)D * DFF * 2;
constexpr size_t WS_WIN_V = WS_WIN_M + (size_t)4608 * D * 2;
constexpr size_t WS_WGLU = WS_WIN_V + (size_t)D * D * 2;
constexpr size_t WS_WPA = WS_WGLU + (size_t)512 * 512 * 2;
constexpr size_t WS_WPS = WS_WPA + (size_t)D * D * 2;
constexpr size_t WS_WOUT = WS_WPS + (size_t)D * 512 * 2;
constexpr size_t WS_W13_2 = WS_WOUT + (size_t)D * D * 2;
constexpr size_t WS_W2_2 = WS_W13_2 + (size_t)2 * DFF * D * 2;
constexpr size_t WS_MOD = WS_W2_2 + (size_t)D * DFF * 2;
constexpr size_t WS_ROPE = al256(WS_MOD + (size_t)17 * NMODC * 4);
constexpr size_t WS_S5A = WS_ROPE + (size_t)2 * SEQ * 32 * 4;
constexpr size_t WS_SBB = WS_S5A + (size_t)2 * 2 * 32 * 64 * 4;
constexpr size_t WS_SCM = WS_SBB + (size_t)2 * 32 * 128 * 16 * 2;
constexpr size_t WS_LAM = WS_SCM + (size_t)2 * 32 * 16 * 128 * 2;
constexpr size_t WS_BAR = WS_LAM + 256;
constexpr size_t WS_X1 = al256(WS_BAR + 256);
constexpr size_t WS_HBUF = WS_X1 + (size_t)TT * D * 4;
constexpr size_t WS_ACT = WS_HBUF + (size_t)TT * D * 2;
constexpr size_t WS_VT = WS_ACT + (size_t)TT * DFF * 2;
constexpr size_t WS_END = WS_VT + (size_t)NB * NH * LK * 128 * 2;
constexpr size_t WS_Y = WS_HBUF;
constexpr size_t WS_QB = WS_ACT;
constexpr size_t WS_KB = WS_QB + (size_t)TX * D * 2;
constexpr size_t WS_UG = WS_KB + (size_t)NB * NH * LK * 128 * 2;
constexpr size_t WS_YG = WS_KB;
constexpr size_t WS_SX = WS_KB + (size_t)TX * 512 * 2;
constexpr size_t WS_MBUF = WS_VT;
static_assert(WS_UG + (size_t)NB * 32 * LK * 16 * 2 <= WS_VT, "overlay overflow");
static_assert(WS_SX + (size_t)TX * 512 * 2 <= WS_UG, "overlay overflow");

constexpr int LDS_BYTES = 157696;

struct Args { const float* in[34]; float* out; unsigned char* ws; int ph_lo, ph_hi; };

typedef __bf16 bf16x2_t __attribute__((ext_vector_type(2)));
typedef float f32x2_t __attribute__((ext_vector_type(2)));
__device__ __forceinline__ unsigned pk2(float lo, float hi) { f32x2_t v = {lo, hi}; bf16x2_t r = __builtin_convertvector(v, bf16x2_t); return __builtin_bit_cast(unsigned, r); }
__device__ __forceinline__ float bf2f(unsigned short b) { return __uint_as_float(((unsigned)b) << 16); }
__device__ __forceinline__ float bflo(unsigned w) { return __uint_as_float(w << 16); }
__device__ __forceinline__ float bfhi(unsigned w) { return __uint_as_float(w & 0xffff0000u); }
__device__ __forceinline__ float fexp2(float x) { return __builtin_amdgcn_exp2f(x); }
__device__ __forceinline__ float frcp(float x) { return __builtin_amdgcn_rcpf(x); }
__device__ __forceinline__ float sigmoidf_(float x) { return frcp(1.f + fexp2(-1.4426950408889634f * x)); }
__device__ __forceinline__ float siluf_(float x) { return x * sigmoidf_(x); }
__device__ __forceinline__ float gelu_tanh(float x) { const float u = 0.7978845608028654f * (x + 0.044715f * x * x * x); return x * sigmoidf_(2.f * u); }
__device__ __forceinline__ float wave_sum(float v) {
#pragma unroll
    for (int o = 1; o < 64; o <<= 1) v += __shfl_xor(v, o);
    return v;
}
__device__ __forceinline__ int opq(int x) { asm volatile("" : "+v"(x)); return x; }
__device__ __forceinline__ int lane_id() { return (int)__builtin_amdgcn_mbcnt_hi(~0u, __builtin_amdgcn_mbcnt_lo(~0u, 0u)); }
#define LDS_WAIT() asm volatile("s_waitcnt lgkmcnt(0)" ::: "memory")
#define CFENCE() asm volatile("" ::: "memory")

namespace pg8 {
constexpr int BM = 256, BK = 64, HALF = 128, HTB = HALF * BK * 2, STAGE_BYTES = 8 * HTB, NXCD = 8, WGM = 4;
__host__ __device__ __forceinline__ int lds_byte(int r, int c) { const int st = (r >> 4) * 2 + (c >> 5), rr = r & 15, cc = c & 31, ob = rr * 64 + cc * 2; return st * 1024 + (ob ^ (((ob >> 9) & 1) << 5)); }
__host__ __device__ __forceinline__ void stage_rc(int b, int& R, int& C) { const int st = b / 1024, sb = b % 1024, swz = sb ^ (((sb >> 9) & 1) << 5); R = (st >> 1) * 16 + swz / 64; C = (st & 1) * 32 + (swz % 64) / 2; }
__host__ __device__ __forceinline__ int perm32(int rho) { const int n = rho >> 4, i = rho & 15; return 8 * (i >> 2) + 4 * n + (i & 3); }
struct Unit { int pm, pn; };
struct Gemm { const bf16_t* A; const bf16_t* Bt; int K; };

struct SegOrder {
    int nM1, nN1, n1, pm2, nM2, pn2, nN2, n2, G, c;
    __device__ __forceinline__ void init(int nM1_, int nN1_, int pm2_, int nM2_, int pn2_, int nN2_, int G_, int c_) {
        nM1 = nM1_; nN1 = nN1_; n1 = nM1 * nN1; pm2 = pm2_; nM2 = nM2_; pn2 = pn2_; nN2 = nN2_; n2 = nM2 * nN2; G = G_; c = c_; }
    __device__ __forceinline__ bool next(int i, Unit& u) const {
        long L = (long)i * G + c;
        if (L < n1) {
            int wgid = (int)L; { const int q = n1 / NXCD, r = n1 % NXCD, xcd = wgid % NXCD, off = wgid / NXCD; wgid = (xcd < r ? xcd * (q + 1) : r * (q + 1) + (xcd - r) * q) + off; }
            const int nig = WGM * nN1, gid = wgid / nig, fm = gid * WGM, gsz = (nM1 - fm) < WGM ? (nM1 - fm) : WGM;
            u.pm = fm + ((wgid % nig) % gsz); u.pn = (wgid % nig) / gsz; return true;
        }
        L -= n1; if (L >= n2) return false;
        u.pm = pm2 + (int)(L / nN2); u.pn = pn2 + (int)(L % nN2); return true;
    }
};

template <class Epi, bool SWAP>
__device__ __forceinline__ void gemm_phase(LAS unsigned char* lds, const Gemm g, const SegOrder& S, const Epi& E, int wid) {
    const int lane = opq(lane_id()), tid = wid * 64 + lane, wr = wid >> 2, wc = wid & 3, fr = lane & 15, fq = lane >> 4;
    const int K = g.K, nt = K / BK;
    unsigned voffA[2], voffB[2];
#pragma unroll
    for (int i = 0; i < 2; ++i) { int R, C; stage_rc(tid * 16 + i * 8192, R, C); const int Rb = Epi::PERM ? ((R & ~31) + perm32(R & 31)) : R;
        voffA[i] = (unsigned)(R * K + C) * 2u; voffB[i] = (unsigned)(Rb * K + C) * 2u; }
    const size_t kstep = (size_t)(BK * 2);
    const size_t hstep = (size_t)HALF * K * 2;
    const size_t tstep = 2 * hstep;
    const unsigned ldsw = (unsigned)wid * 1024u;
    const int aoff = lds_byte(wr * 64 + fr, fq * 8), boff = lds_byte(wc * 32 + fr, fq * 8);
#define PG8_SA(b, h) (((b) * 2 + (h)) * HTB)
#define PG8_SB(b, h) ((4 + (b) * 2 + (h)) * HTB)
#define PG8_STAGE(bufoff, gbase, voff) do { _Pragma("unroll") for (int _i = 0; _i < 2; ++_i) \
        __builtin_amdgcn_global_load_lds((const unsigned*)((const char*)(gbase) + (voff)[_i]), (LAS unsigned*)(lds + (bufoff) + ldsw + _i * 8192), 16, 0, 0); } while (0)
#define PG8_LDA(dst, b, h) do { _Pragma("unroll") for (int m = 0; m < 4; ++m) _Pragma("unroll") for (int k = 0; k < 2; ++k) dst[m][k] = *(const LAS bf16x8*)(lds + PG8_SA(b, h) + aoff + m * 2048 + k * 1024); } while (0)
#define PG8_LDB(dst, b, h) do { _Pragma("unroll") for (int n = 0; n < 2; ++n) _Pragma("unroll") for (int k = 0; k < 2; ++k) dst[n][k] = *(const LAS bf16x8*)(lds + PG8_SB(b, h) + boff + n * 2048 + k * 1024); } while (0)
#define PG8_MMA(ai, bj, At, Bt) do { __builtin_amdgcn_s_setprio(1); _Pragma("unroll") for (int m = 0; m < 4; ++m) _Pragma("unroll") for (int n = 0; n < 2; ++n) _Pragma("unroll") for (int k = 0; k < 2; ++k) \
        acc[ai][bj][m][n] = SWAP ? __builtin_amdgcn_mfma_f32_16x16x32_bf16(At[m][k], Bt[n][k], acc[ai][bj][m][n], 0, 0, 0) \
                                 : __builtin_amdgcn_mfma_f32_16x16x32_bf16(Bt[n][k], At[m][k], acc[ai][bj][m][n], 0, 0, 0); __builtin_amdgcn_s_setprio(0); } while (0)
#define PG8_WAIT_V(n) asm volatile("s_waitcnt vmcnt(" #n ")" ::: "memory")
#define PG8_WAIT_L(n) asm volatile("s_waitcnt lgkmcnt(" #n ")" ::: "memory")
#define PG8_BAR __builtin_amdgcn_s_barrier()
#define PG8_SCHED __builtin_amdgcn_sched_barrier(0)
    Unit cur, nxt; int ui = 0;
    if (!S.next(0, cur)) return;
    f32x4 acc[2][2][4][2];
#pragma unroll
    for (int a = 0; a < 2; ++a)
#pragma unroll
        for (int b = 0; b < 2; ++b)
#pragma unroll
            for (int m = 0; m < 4; ++m)
#pragma unroll
                for (int n = 0; n < 2; ++n) acc[a][b][m][n] = (f32x4){0.f, 0.f, 0.f, 0.f};
    bf16x8 At[4][2], B0[2][2], B1[2][2];
    const char* cA = (const char*)g.A + (size_t)cur.pm * tstep; const char* cB = (const char*)g.Bt + (size_t)cur.pn * tstep;
    PG8_STAGE(PG8_SB(0, 0), cB, voffB); PG8_STAGE(PG8_SB(0, 1), cB + hstep, voffB); PG8_STAGE(PG8_SA(0, 0), cA, voffA); PG8_STAGE(PG8_SA(0, 1), cA + hstep, voffA);
    if (wr == 1) PG8_BAR;
    PG8_WAIT_V(2); PG8_BAR;
    PG8_STAGE(PG8_SB(1, 0), cB + kstep, voffB); PG8_STAGE(PG8_SA(1, 0), cA + kstep, voffA); PG8_STAGE(PG8_SB(1, 1), cB + hstep + kstep, voffB);
    PG8_WAIT_V(6); PG8_BAR;
    for (;;) {
        const bool has_next = S.next(ui + 1, nxt);
        const char* nA = has_next ? (const char*)g.A + (size_t)nxt.pm * tstep : cA; const char* nB = has_next ? (const char*)g.Bt + (size_t)nxt.pn * tstep : cB;
        for (int t = 0; t < nt; t += 2) {
            const bool last = (t == nt - 2);
            const char* a1 = cA + (size_t)(t + 1) * kstep;
            const char* a2 = last ? nA : cA + (size_t)(t + 2) * kstep; const char* b2 = last ? nB : cB + (size_t)(t + 2) * kstep;
            const char* a3 = a2 + kstep; const char* b3 = b2 + kstep;
            PG8_LDB(B0, 0, 0); PG8_LDB(B1, 0, 1); PG8_SCHED; PG8_LDA(At, 0, 0); PG8_STAGE(PG8_SA(1, 1), a1 + hstep, voffA);
            PG8_WAIT_V(8); PG8_WAIT_L(0); PG8_BAR; PG8_MMA(0, 0, At, B0); PG8_MMA(0, 1, At, B1); PG8_BAR; PG8_SCHED;
            PG8_LDA(At, 0, 1); PG8_STAGE(PG8_SB(0, 0), b2, voffB); PG8_STAGE(PG8_SB(0, 1), b2 + hstep, voffB); PG8_STAGE(PG8_SA(0, 0), a2, voffA);
            PG8_WAIT_V(8); PG8_WAIT_L(0); PG8_BAR; PG8_MMA(1, 0, At, B0); PG8_MMA(1, 1, At, B1); PG8_BAR; PG8_SCHED;
            PG8_LDB(B0, 1, 0); PG8_LDB(B1, 1, 1); PG8_SCHED; PG8_LDA(At, 1, 0); PG8_STAGE(PG8_SA(0, 1), a2 + hstep, voffA);
            PG8_WAIT_V(8); PG8_WAIT_L(0); PG8_BAR; PG8_MMA(0, 0, At, B0); PG8_MMA(0, 1, At, B1); PG8_BAR; PG8_SCHED;
            PG8_LDA(At, 1, 1); PG8_STAGE(PG8_SB(1, 0), b3, voffB); PG8_STAGE(PG8_SB(1, 1), b3 + hstep, voffB); PG8_STAGE(PG8_SA(1, 0), a3, voffA);
            PG8_WAIT_V(8); PG8_WAIT_L(0); PG8_BAR; PG8_MMA(1, 0, At, B0); PG8_MMA(1, 1, At, B1); PG8_BAR; PG8_SCHED;
        }
        if (wr == 0) PG8_BAR;
        E(acc, cur, wr, wc, fr, fq);
        if (!has_next) break;
#pragma unroll
        for (int a = 0; a < 2; ++a)
#pragma unroll
            for (int b = 0; b < 2; ++b)
#pragma unroll
                for (int m = 0; m < 4; ++m)
#pragma unroll
                    for (int n = 0; n < 2; ++n) acc[a][b][m][n] = (f32x4){0.f, 0.f, 0.f, 0.f};
        cur = nxt; cA = nA; cB = nB; ++ui;
        if (wr == 1) PG8_BAR;
    }
    PG8_WAIT_V(0);
    PG8_BAR;
#undef PG8_SA
#undef PG8_SB
#undef PG8_STAGE
#undef PG8_LDA
#undef PG8_LDB
#undef PG8_MMA
#undef PG8_WAIT_V
#undef PG8_WAIT_L
#undef PG8_BAR
#undef PG8_SCHED
}
}
using pg8::Unit;


struct EpiSwiglu {
    static constexpr bool PERM = true;
    bf16_t* O;
    __device__ __forceinline__ void operator()(const f32x4 (&acc)[2][2][4][2], const Unit& u, int wr, int wc, int fr, int fq) const {
        const int row0 = u.pm * 256 + wr * 64 + fr, col0 = u.pn * 128 + wc * 32 + 8 * fq;
#pragma unroll
        for (int ai = 0; ai < 2; ++ai)
#pragma unroll
            for (int m = 0; m < 4; ++m) {
                const f32x4 a0 = acc[ai][0][m][0], a1 = acc[ai][0][m][1], b0 = acc[ai][1][m][0], b1 = acc[ai][1][m][1];
                u32x4 w;
                w.x = pk2(siluf_(a0[0]) * b0[0], siluf_(a0[1]) * b0[1]); w.y = pk2(siluf_(a0[2]) * b0[2], siluf_(a0[3]) * b0[3]);
                w.z = pk2(siluf_(a1[0]) * b1[0], siluf_(a1[1]) * b1[1]); w.w = pk2(siluf_(a1[2]) * b1[2], siluf_(a1[3]) * b1[3]);
                *(u32x4*)(O + (size_t)(row0 + ai * 128 + m * 16) * DFF + col0) = w;
            }
    }
};

struct EpiResid {
    static constexpr bool PERM = false;
    const float* srcX; const float* srcC; float* dst; const float* gate; float coef;
    __device__ __forceinline__ void operator()(const f32x4 (&acc)[2][2][4][2], const Unit& u, int wr, int wc, int fr, int fq) const {
        const int mb = u.pm < 256 ? (u.pm >> 4) : 16;
        const float* sp = u.pm < 256 ? srcX + (size_t)u.pm * 256 * D : srcC + (size_t)(u.pm - 256) * 256 * D;
        float* dp = dst + (size_t)u.pm * 256 * D;
        const int rl = wr * 64 + fr, col0 = u.pn * 256 + wc * 32 + 4 * fq;
        f32x4 gv[2][2];
#pragma unroll
        for (int bj = 0; bj < 2; ++bj)
#pragma unroll
            for (int n = 0; n < 2; ++n) gv[bj][n] = *(const f32x4*)(gate + (size_t)mb * NMODC + col0 + bj * 128 + n * 16) * coef;
#pragma unroll
        for (int ai = 0; ai < 2; ++ai)
#pragma unroll
            for (int m = 0; m < 4; ++m) {
                const size_t ro = (size_t)(rl + ai * 128 + m * 16) * D + col0;
#pragma unroll
                for (int bj = 0; bj < 2; ++bj)
#pragma unroll
                    for (int n = 0; n < 2; ++n) { const f32x4 s = *(const f32x4*)(sp + ro + bj * 128 + n * 16); *(f32x4*)(dp + ro + bj * 128 + n * 16) = s + gv[bj][n] * acc[ai][bj][m][n]; }
            }
    }
};

struct EpiInMain {
    static constexpr bool PERM = true;
    bf16_t* QB; bf16_t* KB; bf16_t* UG; bf16_t* GA; bf16_t* GS; const float* qn; const float* kn; const float* ropec; const float* ropes;
    __device__ __forceinline__ void operator()(const f32x4 (&acc)[2][2][4][2], const Unit& u, int wr, int wc, int fr, int fq) const {
        const int pn = u.pn; const bool isx = u.pm < 256;
        const int rl = wr * 64 + fr;
        if (pn < 8) {
            const bool isq = pn < 4;
            const float* gn = isq ? qn : kn;
            f32x4 g[2][2];
#pragma unroll
            for (int bj = 0; bj < 2; ++bj)
#pragma unroll
                for (int n = 0; n < 2; ++n) g[bj][n] = *(const f32x4*)(gn + 32 * bj + 8 * fq + 4 * n);
            const int hcg = 4 * (pn & 3) + wc, head = hcg >> 1, comp = hcg & 1;
#pragma unroll
            for (int ai = 0; ai < 2; ++ai)
#pragma unroll
                for (int m = 0; m < 4; ++m) {
                    const int r = u.pm * 256 + rl + ai * 128 + m * 16;
                    f32x4 v[2][2]; float ss = 0.f;
#pragma unroll
                    for (int bj = 0; bj < 2; ++bj)
#pragma unroll
                        for (int n = 0; n < 2; ++n) { v[bj][n] = acc[ai][bj][m][n]; ss += (v[bj][n][0] * v[bj][n][0] + v[bj][n][1] * v[bj][n][1]) + (v[bj][n][2] * v[bj][n][2] + v[bj][n][3] * v[bj][n][3]); }
                    ss += __shfl_xor(ss, 16); ss += __shfl_xor(ss, 32);
                    const float rstd = rsqrtf(ss * (1.f / 64.f) + EPS);
#pragma unroll
                    for (int bj = 0; bj < 2; ++bj)
#pragma unroll
                        for (int n = 0; n < 2; ++n) v[bj][n] = v[bj][n] * rstd * g[bj][n];
                    if (isx) {
                        const int t = r & (SEQ - 1);
#pragma unroll
                        for (int n = 0; n < 2; ++n) {
                            const f32x4 cs = *(const f32x4*)(ropec + t * 32 + 8 * fq + 4 * n), sn = *(const f32x4*)(ropes + t * 32 + 8 * fq + 4 * n);
                            const f32x4 t1 = v[0][n], t2 = v[1][n];
                            v[0][n] = t1 * cs - t2 * sn; v[1][n] = t2 * cs + t1 * sn;
                        }
                    }
                    bf16_t* dstp;
                    if (isq) {
#pragma unroll
                        for (int bj = 0; bj < 2; ++bj)
#pragma unroll
                            for (int n = 0; n < 2; ++n) v[bj][n] = v[bj][n] * QSCALE;
                        dstp = QB + (size_t)r * D + hcg * 64 + 8 * fq;
                    } else {
                        int b, pos; if (isx) { b = r >> 12; pos = LC + (r & (SEQ - 1)); } else { const int rc = r - TX; b = rc >> 8; pos = rc & (LC - 1); }
                        dstp = KB + (((size_t)(b * NH + head) * LK + pos) * 2 + comp) * 64 + 8 * fq;
                    }
#pragma unroll
                    for (int bj = 0; bj < 2; ++bj) {
                        u32x4 w; w.x = pk2(v[bj][0][0], v[bj][0][1]); w.y = pk2(v[bj][0][2], v[bj][0][3]); w.z = pk2(v[bj][1][0], v[bj][1][1]); w.w = pk2(v[bj][1][2], v[bj][1][3]);
                        *(u32x4*)(dstp + 32 * bj) = w;
                    }
                }
        } else if (pn < 10) {
#pragma unroll
            for (int ai = 0; ai < 2; ++ai)
#pragma unroll
                for (int m = 0; m < 4; ++m) {
                    const int r = u.pm * 256 + rl + ai * 128 + m * 16;
                    int b, pos; if (isx) { b = r >> 12; pos = LC + (r & (SEQ - 1)); } else { const int rc = r - TX; b = rc >> 8; pos = rc & (LC - 1); }
#pragma unroll
                    for (int bj = 0; bj < 2; ++bj) {
                        const int ch0 = 256 * (pn - 8) + 128 * bj + 32 * wc + 8 * fq, gidx = ch0 >> 4, c0 = ch0 & 15;
                        const f32x4 v0 = acc[ai][bj][m][0], v1 = acc[ai][bj][m][1];
                        u32x4 w; w.x = pk2(v0[0], v0[1]); w.y = pk2(v0[2], v0[3]); w.z = pk2(v1[0], v1[1]); w.w = pk2(v1[2], v1[3]);
                        *(u32x4*)(UG + ((size_t)(b * 32 + gidx) * LK + pos) * 16 + c0) = w;
                    }
                }
        } else {
            bf16_t* Gd = pn < 14 ? GA : GS; const int pq = pn < 14 ? pn - 10 : pn - 14;
#pragma unroll
            for (int ai = 0; ai < 2; ++ai)
#pragma unroll
                for (int m = 0; m < 4; ++m) {
                    const int r = u.pm * 256 + rl + ai * 128 + m * 16;
#pragma unroll
                    for (int bj = 0; bj < 2; ++bj) {
                        const f32x4 v0 = acc[ai][bj][m][0], v1 = acc[ai][bj][m][1];
                        u32x4 w; w.x = pk2(sigmoidf_(v0[0]), sigmoidf_(v0[1])); w.y = pk2(sigmoidf_(v0[2]), sigmoidf_(v0[3])); w.z = pk2(sigmoidf_(v1[0]), sigmoidf_(v1[1])); w.w = pk2(sigmoidf_(v1[2]), sigmoidf_(v1[3]));
                        *(u32x4*)(Gd + (size_t)r * D + 256 * pq + 128 * bj + 32 * wc + 8 * fq) = w;
                    }
                }
        }
    }
};

struct EpiInV {
    static constexpr bool PERM = false;
    bf16_t* VT;
    __device__ __forceinline__ void operator()(const f32x4 (&acc)[2][2][4][2], const Unit& u, int wr, int wc, int fr, int fq) const {
        const bool isx = u.pm < 256;
#pragma unroll
        for (int ai = 0; ai < 2; ++ai)
#pragma unroll
            for (int m = 0; m < 4; ++m) {
                const int r = u.pm * 256 + ai * 128 + wr * 64 + m * 16 + 4 * fq;
                int b, pos; if (isx) { b = r >> 12; pos = LC + (r & (SEQ - 1)); } else { const int rc = r - TX; b = rc >> 8; pos = rc & (LC - 1); }
                const int tile = pos >> 6, kp = pos & 63, k16 = kp & 15, sp = (kp & 48) + 8 * ((k16 >> 2) & 1) + 4 * (k16 >> 3);
#pragma unroll
                for (int bj = 0; bj < 2; ++bj)
#pragma unroll
                    for (int n = 0; n < 2; ++n) {
                        const int col = u.pn * 256 + bj * 128 + wc * 32 + n * 16 + fr, h = col >> 7, dv = col & 127;
                        const f32x4 v = acc[ai][bj][m][n];
                        u32x2 w; w.x = pk2(v[0], v[1]); w.y = pk2(v[2], v[3]);
                        *(u32x2*)(VT + (((size_t)(b * NH + h) * NKT + tile) * 128 + dv) * 64 + sp) = w;
                    }
            }
    }
};

struct EpiGlu {
    static constexpr bool PERM = true;
    const bf16_t* YG; bf16_t* SX; const float* bglu;
    __device__ __forceinline__ void operator()(const f32x4 (&acc)[2][2][4][2], const Unit& u, int wr, int wc, int fr, int fq) const {
        const int row0 = u.pm * 256 + wr * 64 + fr, col0 = u.pn * 256 + wc * 32 + 8 * fq;
#pragma unroll
        for (int bj = 0; bj < 2; ++bj) {
            const f32x4 bv0 = *(const f32x4*)(bglu + col0 + bj * 128), bv1 = *(const f32x4*)(bglu + col0 + bj * 128 + 4);
#pragma unroll
            for (int ai = 0; ai < 2; ++ai)
#pragma unroll
                for (int m = 0; m < 4; ++m) {
                    const size_t o = (size_t)(row0 + ai * 128 + m * 16) * 512 + col0 + bj * 128;
                    const u32x4 y = *(const u32x4*)(YG + o);
                    const f32x4 v0 = acc[ai][bj][m][0] + bv0, v1 = acc[ai][bj][m][1] + bv1;
                    u32x4 w;
                    w.x = pk2(bflo(y.x) * sigmoidf_(v0[0]), bfhi(y.x) * sigmoidf_(v0[1])); w.y = pk2(bflo(y.y) * sigmoidf_(v0[2]), bfhi(y.y) * sigmoidf_(v0[3]));
                    w.z = pk2(bflo(y.z) * sigmoidf_(v1[0]), bfhi(y.z) * sigmoidf_(v1[1])); w.w = pk2(bflo(y.w) * sigmoidf_(v1[2]), bfhi(y.w) * sigmoidf_(v1[3]));
                    *(u32x4*)(SX + o) = w;
                }
        }
    }
};

template <bool ACCUM> struct EpiMerge {
    static constexpr bool PERM = true;
    const bf16_t* Gt; bf16_t* Mb;
    __device__ __forceinline__ void operator()(const f32x4 (&acc)[2][2][4][2], const Unit& u, int wr, int wc, int fr, int fq) const {
        const int row0 = u.pm * 256 + wr * 64 + fr, col0 = u.pn * 256 + wc * 32 + 8 * fq;
#pragma unroll
        for (int ai = 0; ai < 2; ++ai)
#pragma unroll
            for (int m = 0; m < 4; ++m)
#pragma unroll
                for (int bj = 0; bj < 2; ++bj) {
                    const size_t o = (size_t)(row0 + ai * 128 + m * 16) * D + col0 + bj * 128;
                    const u32x4 gt = *(const u32x4*)(Gt + o);
                    const f32x4 v0 = acc[ai][bj][m][0], v1 = acc[ai][bj][m][1];
                    float r0 = bflo(gt.x) * v0[0], r1 = bfhi(gt.x) * v0[1], r2 = bflo(gt.y) * v0[2], r3 = bfhi(gt.y) * v0[3];
                    float r4 = bflo(gt.z) * v1[0], r5 = bfhi(gt.z) * v1[1], r6 = bflo(gt.w) * v1[2], r7 = bfhi(gt.w) * v1[3];
                    if (ACCUM) { const u32x4 p = *(const u32x4*)(Mb + o);
                        r0 += bflo(p.x); r1 += bfhi(p.x); r2 += bflo(p.y); r3 += bfhi(p.y); r4 += bflo(p.z); r5 += bfhi(p.z); r6 += bflo(p.w); r7 += bfhi(p.w); }
                    u32x4 w; w.x = pk2(r0, r1); w.y = pk2(r2, r3); w.z = pk2(r4, r5); w.w = pk2(r6, r7);
                    *(u32x4*)(Mb + o) = w;
                }
    }
};

__device__ __forceinline__ void tr_item(const float* W, int K, int N, int k0, int scol0, bf16_t* WT, int drow0, LAS float* scr, int lane) {
#pragma unroll 8
    for (int i = 0; i < 32; ++i) { const int kk = 2 * i + (lane >> 5); scr[kk * 33 + (lane & 31)] = W[(size_t)(k0 + kk) * N + scol0 + (lane & 31)]; }
    LDS_WAIT();
    const int c = lane & 7;
#pragma unroll
    for (int j = 0; j < 4; ++j) { const int n = (lane >> 3) + 8 * j; const LAS float* s = scr + (8 * c) * 33 + n;
        u32x4 o; o.x = pk2(s[0 * 33], s[1 * 33]); o.y = pk2(s[2 * 33], s[3 * 33]); o.z = pk2(s[4 * 33], s[5 * 33]); o.w = pk2(s[6 * 33], s[7 * 33]);
        *(u32x4*)(WT + (size_t)(drow0 + n) * K + k0 + 8 * c) = o; }
    LDS_WAIT();
}
__device__ __forceinline__ int src_w13(int n0) { const int pn = n0 >> 8, s = n0 & 255; return (s >> 7) * DFF + 128 * pn + (s & 127); }
__device__ __forceinline__ int src_winm(int n0) {
    if (n0 < 2048) { const int base = n0 < 1024 ? 0 : 1024, nn = n0 - base, pn = nn >> 8, s = nn & 255, bj = s >> 7, wc = (s & 127) >> 5, hcg = 4 * pn + wc; return base + hcg * 64 + 32 * bj; }
    if (n0 < 2560) return 3072 + (n0 - 2048);
    return 3584 + (n0 - 2560);
}

__global__ void __launch_bounds__(512, 2) mega(Args a) {
    extern __shared__ __attribute__((aligned(16))) unsigned char smem[];
    LAS unsigned char* lds = (LAS unsigned char*)smem;
    const int wave = __builtin_amdgcn_readfirstlane(threadIdx.x >> 6);
    const int G = gridDim.x, cb = blockIdx.x;
    const int gw = cb * 8 + wave, NW = G * 8;
    unsigned char* ws = a.ws;
    bf16_t* W13_1 = (bf16_t*)(ws + WS_W13_1); bf16_t* W2_1 = (bf16_t*)(ws + WS_W2_1); bf16_t* WINM = (bf16_t*)(ws + WS_WIN_M); bf16_t* WINV = (bf16_t*)(ws + WS_WIN_V);
    bf16_t* WGLU = (bf16_t*)(ws + WS_WGLU); bf16_t* WPA = (bf16_t*)(ws + WS_WPA); bf16_t* WPS = (bf16_t*)(ws + WS_WPS); bf16_t* WOUT = (bf16_t*)(ws + WS_WOUT);
    bf16_t* W13_2 = (bf16_t*)(ws + WS_W13_2); bf16_t* W2_2 = (bf16_t*)(ws + WS_W2_2);
    float* MOD = (float*)(ws + WS_MOD); float* ROPEC = (float*)(ws + WS_ROPE); float* ROPES = ROPEC + SEQ * 32;
    float* S5AR = (float*)(ws + WS_S5A); float* S5AI = S5AR + 2 * 32 * 64; bf16_t* SBB = (bf16_t*)(ws + WS_SBB); bf16_t* SCM = (bf16_t*)(ws + WS_SCM); float* LAMP = (float*)(ws + WS_LAM);
    float* X1 = (float*)(ws + WS_X1); bf16_t* HBUF = (bf16_t*)(ws + WS_HBUF); bf16_t* ACT = (bf16_t*)(ws + WS_ACT); bf16_t* VT = (bf16_t*)(ws + WS_VT);
    bf16_t* YB = (bf16_t*)(ws + WS_Y); bf16_t* QB = (bf16_t*)(ws + WS_QB); bf16_t* KB = (bf16_t*)(ws + WS_KB); bf16_t* UG = (bf16_t*)(ws + WS_UG);
    bf16_t* YG = (bf16_t*)(ws + WS_YG); bf16_t* SX = (bf16_t*)(ws + WS_SX); bf16_t* MBUF = (bf16_t*)(ws + WS_MBUF);
    bf16_t* GA = (bf16_t*)a.out; bf16_t* GS = GA + (size_t)TX * D;
    const float* Xin = a.in[0]; const float* Cin = a.in[2];

#ifndef PHMASK
#define PHMASK 0x7fff
#endif
#define PH(n) if (((PHMASK >> (n)) & 1) && a.ph_lo <= (n) && (n) < a.ph_hi)
#if MK_SPLIT
#define GSYNC(n) do { } while (0)
#else
#define GSYNC(n) do { if (a.ph_lo <= (n) && (n) + 1 < a.ph_hi) { bar_t += (unsigned)G; \
        asm volatile("s_waitcnt vmcnt(0) lgkmcnt(0)" ::: "memory");       \
        __syncthreads(); \
        if (wave == 0) {                                                   \
            __builtin_amdgcn_fence(__ATOMIC_RELEASE, "agent"); asm volatile("s_waitcnt vmcnt(0)" ::: "memory"); \
            if (lane_id() == 0) { __hip_atomic_fetch_add(BARW, 1u, __ATOMIC_RELAXED, __HIP_MEMORY_SCOPE_AGENT); \
                while (__hip_atomic_load(BARW, __ATOMIC_RELAXED, __HIP_MEMORY_SCOPE_AGENT) < bar_t) __builtin_amdgcn_s_sleep(1); } \
            __builtin_amdgcn_fence(__ATOMIC_ACQUIRE, "agent"); asm volatile("s_waitcnt vmcnt(0) lgkmcnt(0)" ::: "memory"); } \
        __syncthreads(); } } while (0)
#endif
    unsigned* BARW = (unsigned*)(ws + WS_BAR); unsigned bar_t = 0;
#if !MK_SPLIT
    if (a.ph_lo == 0) cg::this_grid().sync();
#endif

    PH(0) {
        const int lane = opq(lane_id()), tid = wave * 64 + lane;
        for (int slab = cb; slab < NMODC / 64; slab += G) {
            LAS float* sl = (LAS float*)lds;
            LAS float* red = (LAS float*)(lds + 17 * 1024 * 4);
            for (int i = tid; i < 17 * 1024; i += 512) { const int mb = i >> 10, k = i & 1023; const float v = mb < 16 ? a.in[1][mb * 1024 + k] : a.in[3][k]; sl[i] = siluf_(v); }
            __syncthreads();
            float accm[17];
#pragma unroll
            for (int j = 0; j < 17; ++j) accm[j] = 0.f;
            const float* wp = a.in[4] + (size_t)(wave * 128) * NMODC + slab * 64 + lane;
#pragma unroll 4
            for (int k = 0; k < 128; ++k) { const float w = wp[(size_t)k * NMODC];
#pragma unroll
                for (int j = 0; j < 17; ++j) accm[j] += w * sl[j * 1024 + wave * 128 + k]; }
#pragma unroll
            for (int j = 0; j < 17; ++j) red[(wave * 17 + j) * 64 + lane] = accm[j];
            __syncthreads();
            for (int i = tid; i < 17 * 64; i += 512) { const int j = i >> 6, l = i & 63; float s = a.in[5][slab * 64 + l];
#pragma unroll
                for (int w = 0; w < 8; ++w) s += red[(w * 17 + j) * 64 + l];
                MOD[(size_t)j * NMODC + slab * 64 + l] = s; }
            __syncthreads();
        }
        {
            LAS float* scr = (LAS float*)(lds + wave * 16384);
            constexpr int I13 = 16 * 176, I2 = 44 * 32, IINM = 16 * 144, IINV = 16 * 32, IGLU = 8 * 16, IPA = 16 * 32, IPS = 8 * 32, IOUT = 16 * 32;
            constexpr int NIT = 2 * I13 + 2 * I2 + IINM + IINV + IGLU + IPA + IPS + IOUT;
            for (int it = gw; it < NIT; it += NW) {
                int r = it;
                if (r < I13) { const int kb = r / 176, nb = r % 176; tr_item(a.in[7], D, 2 * DFF, 64 * kb, src_w13(32 * nb), W13_1, 32 * nb, scr, lane); continue; } r -= I13;
                if (r < I13) { const int kb = r / 176, nb = r % 176; tr_item(a.in[32], D, 2 * DFF, 64 * kb, src_w13(32 * nb), W13_2, 32 * nb, scr, lane); continue; } r -= I13;
                if (r < I2) { const int kb = r / 32, nb = r % 32; tr_item(a.in[8], DFF, D, 64 * kb, 32 * nb, W2_1, 32 * nb, scr, lane); continue; } r -= I2;
                if (r < I2) { const int kb = r / 32, nb = r % 32; tr_item(a.in[33], DFF, D, 64 * kb, 32 * nb, W2_2, 32 * nb, scr, lane); continue; } r -= I2;
                if (r < IINM) { const int kb = r / 144, nb = r % 144; tr_item(a.in[10], D, 5632, 64 * kb, src_winm(32 * nb), WINM, 32 * nb, scr, lane); continue; } r -= IINM;
                if (r < IINV) { const int kb = r / 32, nb = r % 32; tr_item(a.in[10], D, 5632, 64 * kb, 2048 + 32 * nb, WINV, 32 * nb, scr, lane); continue; } r -= IINV;
                if (r < IGLU) { const int kb = r / 16, nb = r % 16; tr_item(a.in[26], 512, 512, 64 * kb, 32 * nb, WGLU, 32 * nb, scr, lane); continue; } r -= IGLU;
                if (r < IPA) { const int kb = r / 32, nb = r % 32; tr_item(a.in[28], D, D, 64 * kb, 32 * nb, WPA, 32 * nb, scr, lane); continue; } r -= IPA;
                if (r < IPS) { const int kb = r / 32, nb = r % 32; tr_item(a.in[29], 512, D, 64 * kb, 32 * nb, WPS, 32 * nb, scr, lane); continue; } r -= IPS;
                { const int kb = r / 32, nb = r % 32; tr_item(a.in[30], D, D, 64 * kb, 32 * nb, WOUT, 32 * nb, scr, lane); }
            }
        }
        for (int i = cb * 512 + tid; i < SEQ * 32; i += G * 512) {
            const int t = i >> 5, f = i & 31; const int pos = f < 16 ? (t >> 6) : (t & 63); const int fi = f & 15;
            const float inv = (float)pow(10000.0, -(double)fi / 16.0); const float ang = (float)pos * inv;
            ROPEC[i] = (float)cos((double)ang); ROPES[i] = (float)sin((double)ang);
        }
        for (int i = cb * 512 + tid; i < 2 * 32 * 64; i += G * 512) {
            const int dg = i >> 6, p = i & 63;
            const double lre = a.in[18][i], lim = a.in[19][i], dt = exp((double)a.in[20][dg]);
            const double mag = exp(lre * dt), ar = mag * cos(lim * dt), ai = mag * sin(lim * dt), den = lre * lre + lim * lim, nr = ar - 1.0;
            const double fr_ = (nr * lre + ai * lim) / den, fi_ = (ai * lre - nr * lim) / den;
            S5AR[i] = (float)ar; S5AI[i] = (float)ai;
            const float* bre = a.in[21] + (size_t)i * 16; const float* bim = a.in[22] + (size_t)i * 16;
#pragma unroll
            for (int c2 = 0; c2 < 16; c2 += 2) {
                const double r0 = fr_ * bre[c2] - fi_ * bim[c2], r1 = fr_ * bre[c2 + 1] - fi_ * bim[c2 + 1], i0 = fr_ * bim[c2] + fi_ * bre[c2], i1 = fr_ * bim[c2 + 1] + fi_ * bre[c2 + 1];
                *(unsigned*)(SBB + ((size_t)dg * 128 + 64 * (p >> 5) + (p & 31)) * 16 + c2) = pk2((float)r0, (float)r1);
                *(unsigned*)(SBB + ((size_t)dg * 128 + 64 * (p >> 5) + 32 + (p & 31)) * 16 + c2) = pk2((float)i0, (float)i1);
            }
        }
        for (int i = cb * 512 + tid; i < 2 * 32 * 16 * 64; i += G * 512) {
            const int p2 = (i & 31) * 2, dgc = i >> 5;
            if (i < 2 * 32 * 16 * 32) {
                const float* cre = a.in[23] + (size_t)dgc * 64; const float* cim = a.in[24] + (size_t)dgc * 64;
                *(unsigned*)(SCM + (size_t)dgc * 128 + 2 * p2) = pk2(cre[p2], -cim[p2]);
                *(unsigned*)(SCM + (size_t)dgc * 128 + 2 * p2 + 2) = pk2(cre[p2 + 1], -cim[p2 + 1]);
            }
        }
        if (cb == 0 && tid == 0) {
            float s1 = 0.f, s2 = 0.f;
            for (int i = 0; i < 64; ++i) { s1 += a.in[13][i] * a.in[14][i]; s2 += a.in[15][i] * a.in[16][i]; }
            LAMP[0] = expf(s1) - expf(s2) + 0.2f;
            float gq = 0.f, gk = 0.f;
            for (int i = 0; i < 64; ++i) { gq = fmaxf(gq, fabsf(a.in[11][i])); gk = fmaxf(gk, fabsf(a.in[12][i])); }
            LAMP[1] = 1.02f * 64.f * gq * gk * QSCALE;
        }
    }
    GSYNC(0);

    auto norm_phase = [&](const float* srcX, const float* srcC, int nrows, const float* gain, int sh_chunk, int sc_chunk) {
        const int nchunk = nrows / 8; const int lane = opq(lane_id());
        for (int ch = gw; ch < nchunk; ch += NW) {
            const int r0 = ch * 8; const int mb = r0 < TX ? (r0 >> 12) : 16;
            f32x4 ga[4], sh[4];
#pragma unroll
            for (int j = 0; j < 4; ++j) { const int c = 4 * lane + 256 * j;
                const f32x4 g4 = *(const f32x4*)(gain + c), sc4 = *(const f32x4*)(MOD + (size_t)mb * NMODC + sc_chunk * D + c);
                ga[j] = g4 * (sc4 + 1.0f); sh[j] = *(const f32x4*)(MOD + (size_t)mb * NMODC + sh_chunk * D + c); }
            for (int rr = 0; rr < 8; ++rr) {
                const int r = r0 + rr;
                const float* xr = r < TX ? srcX + (size_t)r * D : srcC + (size_t)(r - TX) * D;
                f32x4 v[4]; float s = 0.f;
#pragma unroll
                for (int j = 0; j < 4; ++j) { v[j] = *(const f32x4*)(xr + 4 * lane + 256 * j); s += (v[j][0] * v[j][0] + v[j][1] * v[j][1]) + (v[j][2] * v[j][2] + v[j][3] * v[j][3]); }
                const float rstd = rsqrtf(wave_sum(s) * (1.f / D) + EPS);
#pragma unroll
                for (int j = 0; j < 4; ++j) { const f32x4 y = v[j] * rstd * ga[j] + sh[j]; u32x2 w; w.x = pk2(y[0], y[1]); w.y = pk2(y[2], y[3]);
                    *(u32x2*)(HBUF + (size_t)r * D + 4 * lane + 256 * j) = w; }
            }
        }
    };

    PH(1) { norm_phase(Xin, Cin, TT, a.in[6], 0, 1); }
    GSYNC(1);
#ifndef REPG
#define REPG 1
#endif
#pragma unroll 1
    for (int rg = 0; rg < REPG; ++rg)
    PH(2) { pg8::SegOrder S; S.init(272, 22, 0, 0, 0, 1, G, cb); pg8::Gemm g{HBUF, W13_1, D}; EpiSwiglu E{ACT}; pg8::gemm_phase<EpiSwiglu, false>(lds, g, S, E, wave); }
    GSYNC(2);
#pragma unroll 1
    for (int rg = 0; rg < REPG; ++rg)
    PH(3) { pg8::SegOrder S; S.init(272, 4, 0, 0, 0, 1, G, cb); pg8::Gemm g{ACT, W2_1, DFF}; EpiResid E{Xin, Cin, X1, MOD + 2 * D, 0.5f}; pg8::gemm_phase<EpiResid, false>(lds, g, S, E, wave); }
    GSYNC(3);
#ifndef REP56
#define REP56 1
#endif
#pragma unroll 1
    for (int rep56 = 0; rep56 < REP56; ++rep56) {
    PH(4) { norm_phase(X1, X1 + (size_t)TX * D, TT, a.in[9], 3, 4); }
    GSYNC(4);
#ifndef REP5
#define REP5 1
#endif
#pragma unroll 1
    for (int r5 = 0; r5 < REP5; ++r5)
    PH(5) {
        { pg8::SegOrder S; S.init(256, 18, 256, 16, 4, 6, G, cb); pg8::Gemm g{HBUF, WINM, D}; EpiInMain E{QB, KB, UG, GA, GS, a.in[11], a.in[12], ROPEC, ROPES}; pg8::gemm_phase<EpiInMain, false>(lds, g, S, E, wave); }
        { pg8::SegOrder S; S.init(272, 4, 0, 0, 0, 1, G, (cb + G / 2) % G);
          pg8::Gemm g{HBUF, WINV, D}; EpiInV E{VT}; pg8::gemm_phase<EpiInV, true>(lds, g, S, E, wave); }
    }
    GSYNC(5);

    PH(6) {
        const int lane = opq(lane_id()), tid = wave * 64 + lane;
        const int hh = lane >> 5, l31 = lane & 31;
#ifndef REPS
#define REPS 1
#endif
#pragma unroll 1
        for (int rs = 0; rs < REPS; ++rs)
        for (int si = cb; si < 256; si += G) if (wave < 4) {
            const int task = si * 4 + wave, b = task >> 6, d = (task >> 5) & 1, g = task & 31, dg = d * 32 + g;
            LAS unsigned char* wl = lds + wave * 16896;
            const float ar = S5AR[dg * 64 + lane], ai = S5AI[dg * 64 + lane];
            bf16x8 bfr[4], cfr[4];
#pragma unroll
            for (int nt = 0; nt < 4; ++nt) bfr[nt] = *(const bf16x8*)(SBB + ((size_t)dg * 128 + l31 + 32 * nt) * 16 + 8 * hh);
#pragma unroll
            for (int kk = 0; kk < 4; ++kk) cfr[kk] = *(const bf16x8*)(SCM + ((size_t)dg * 16 + (lane & 15)) * 128 + 32 * kk + 8 * (lane >> 4));
            const bf16_t* ug = UG + (size_t)(b * 32 + g) * LK * 16;
            bf16_t* yo = YB + ((size_t)d * TX + (size_t)b * SEQ) * 512 + g * 16;
            float hr = 0.f, hi = 0.f;
            auto upos = [&](int ch) { const int s = 32 * ch + l31; return d == 0 ? s : (s < LC ? LC - 1 - s : LK + LC - 1 - s); };
            bf16x8 afn = *(const bf16x8*)(ug + (size_t)upos(0) * 16 + 8 * hh);
            for (int ch = 0; ch < LK / 32; ++ch) {
                const bf16x8 af = afn;
                if (ch + 1 < LK / 32) afn = *(const bf16x8*)(ug + (size_t)upos(ch + 1) * 16 + 8 * hh);
                f32x16 bu[4];
#pragma unroll
                for (int nt = 0; nt < 4; ++nt) { f32x16 z;
#pragma unroll
                    for (int q = 0; q < 16; ++q) z[q] = 0.f;
                    bu[nt] = __builtin_amdgcn_mfma_f32_32x32x16_bf16(af, bfr[nt], z, 0, 0, 0); }
                float reA[16], reB[16], imA[16], imB[16];
#pragma unroll
                for (int r = 0; r < 16; ++r) {
                    const auto sr = __builtin_amdgcn_permlane32_swap(__float_as_uint(bu[0][r]), __float_as_uint(bu[2][r]), false, false);
                    const auto si_ = __builtin_amdgcn_permlane32_swap(__float_as_uint(bu[1][r]), __float_as_uint(bu[3][r]), false, false);
                    reA[r] = __uint_as_float(sr[0]); reB[r] = __uint_as_float(sr[1]); imA[r] = __uint_as_float(si_[0]); imB[r] = __uint_as_float(si_[1]);
                }
#pragma unroll
                for (int i = 0; i < 4; ++i) {
#pragma unroll
                    for (int j = 0; j < 4; ++j) { const int t = 8 * i + j;
                        const float nhr = fmaf(-ai, hi, fmaf(ar, hr, reA[4 * i + j])), nhi = fmaf(ai, hr, fmaf(ar, hi, imA[4 * i + j]));
                        hr = nhr; hi = nhi; *(LAS unsigned*)(wl + t * 528 + lane * 4) = pk2(hr, hi); }
#pragma unroll
                    for (int j = 0; j < 4; ++j) { const int t = 8 * i + 4 + j;
                        const float nhr = fmaf(-ai, hi, fmaf(ar, hr, reB[4 * i + j])), nhi = fmaf(ai, hr, fmaf(ar, hi, imB[4 * i + j]));
                        hr = nhr; hi = nhi; *(LAS unsigned*)(wl + t * 528 + lane * 4) = pk2(hr, hi); }
                }
                CFENCE();
                if (ch >= LC / 32) {
#pragma unroll
                    for (int mt = 0; mt < 2; ++mt) {
                        f32x4 y = (f32x4){0.f, 0.f, 0.f, 0.f};
#pragma unroll
                        for (int kk = 0; kk < 4; ++kk) { const bf16x8 hf = *(const LAS bf16x8*)(wl + (16 * mt + (lane & 15)) * 528 + (32 * kk + 8 * (lane >> 4)) * 2);
                            y = __builtin_amdgcn_mfma_f32_16x16x32_bf16(cfr[kk], hf, y, 0, 0, 0); }
                        const int s2 = 32 * ch + 16 * mt + (lane & 15);
                        const int tok = d == 0 ? s2 - LC : (LK - 1 - s2);
                        u32x2 w; w.x = pk2(y[0], y[1]); w.y = pk2(y[2], y[3]);
                        *(u32x2*)(yo + (size_t)tok * 512 + 4 * (lane >> 4)) = w;
                    }
                }
                CFENCE();
            }
        }
        __syncthreads();
        const float negC = __builtin_amdgcn_readfirstlane(__float_as_int(LAMP[1] > 64.f ? -LAMP[1] : 0.f)) == 0 ? 0.f : -LAMP[1];
        LAS unsigned* stab = (LAS unsigned*)(lds + 145408 + wave * 1536);
        {
            const int lane = opq(lane_id());
#pragma unroll
            for (int i = 0; i < 3; ++i) { const int slot = 64 * (wave + 8 * i) + lane; int key = slot / 17, c = slot % 17; if (c == 16) c = 0; if (key > 63) key = 63; stab[i * 64 + lane] = (unsigned)(key * 256 + c * 16);
                int dv = slot / 9, c2 = slot % 9; if (c2 == 8) c2 = 0; if (dv > 127) dv = 127; stab[(3 + i) * 64 + lane] = (unsigned)(dv * 128 + c2 * 16); }
        }
            constexpr int KBUF = 17408, VBUF = 18432, VOFF = 2 * KBUF;
#define ATT_STAGE(buf, tile) do { _Pragma("unroll") for (int _i = 0; _i < 3; ++_i) { const int _j = wave + 8 * _i; \
                if (_j < 17) __builtin_amdgcn_global_load_lds((const unsigned*)((const char*)Kg + (size_t)(tile) * 16384 + stab[_i * 64 + lane]), (LAS unsigned*)(lds + (buf) * KBUF + _j * 1024), 16, 0, 0); \
                if (_j < 18) __builtin_amdgcn_global_load_lds((const unsigned*)((const char*)Vg + (size_t)(tile) * 16384 + stab[(3 + _i) * 64 + lane]), (LAS unsigned*)(lds + VOFF + (buf) * VBUF + _j * 1024), 16, 0, 0); } } while (0)
#ifndef REPA
#define REPA 1
#endif
#pragma unroll 1
        for (int repa = 0; repa < REPA; ++repa)
        for (int ai_ = cb; ai_ < NB * NH * 16 * DBG_ATT; ai_ += G) {
            const int lane = opq(lane_id()), hh = lane >> 5, l31 = lane & 31;
            const int cp = ai_ & 255, jr = ai_ >> 8;
            const int bh = 16 * jr + 2 * (cp & 7) + ((cp >> 3) >> 4), qt = (cp >> 3) & 15;
            const int b = bh >> 3, h = bh & 7;
            const int comp = wave >> 2, rg = wave & 3;
            const size_t row0 = (size_t)b * SEQ + qt * 256 + rg * 64;
            const bf16_t* Kg = KB + (size_t)bh * LK * 128; const bf16_t* Vg = VT + (size_t)bh * NKT * 8192;
            ATT_STAGE(0, 0);
            LAS unsigned char* qb_ = lds + 71680 + wave * 9216;
            {
                u32x4 qr[8];
#pragma unroll
                for (int j = 0; j < 8; ++j) { const int q = 8 * j + (lane >> 3), c = lane & 7; qr[j] = *(const u32x4*)(QB + (row0 + q) * D + h * 128 + comp * 64 + c * 8); }
#pragma unroll
                for (int j = 0; j < 8; ++j) { const int q = 8 * j + (lane >> 3), c = lane & 7; *(LAS u32x4*)(qb_ + q * 144 + c * 16) = qr[j]; }
            }
            f32x16 O[2][4];
#pragma unroll
            for (int qs = 0; qs < 2; ++qs)
#pragma unroll
                for (int mt = 0; mt < 4; ++mt)
#pragma unroll
                    for (int q = 0; q < 16; ++q) O[qs][mt][q] = 0.f;
            float lsum[2] = {0.f, 0.f};
#define SOFTMAX_STEP(S, L, P) do { \
            float ps = 0.f; unsigned pw[8]; \
            if (negC != 0.f) { _Pragma("unroll") for (int q = 0; q < 16; ++q) S[q] += negC; } \
            _Pragma("unroll") for (int q = 0; q < 16; q += 2) { const float e0 = fexp2(S[q]), e1 = fexp2(S[q + 1]); ps += e0 + e1; pw[q >> 1] = pk2(e0, e1); } \
            L += ps; \
            { u32x4 t0 = (u32x4){pw[0], pw[1], pw[2], pw[3]}, t1 = (u32x4){pw[4], pw[5], pw[6], pw[7]}; P[0] = __builtin_bit_cast(bf16x8, t0); P[1] = __builtin_bit_cast(bf16x8, t1); } } while (0)
#define ATT_BAR() do { asm volatile("s_waitcnt lgkmcnt(0)" ::: "memory"); __builtin_amdgcn_s_barrier(); asm volatile("" ::: "memory"); } while (0)
            asm volatile("s_waitcnt vmcnt(0)" ::: "memory");
            __syncthreads();
            for (int it = 0; it < NKT; ++it) {
                const int cur = it & 1;
                LAS unsigned char* kb_ = lds + cur * KBUF + l31 * 272 + hh * 16 + comp * 128; LAS unsigned char* vb_ = lds + VOFF + cur * VBUF + l31 * 144 + hh * 16;
                LAS unsigned char* qa_ = qb_ + l31 * 144 + hh * 16;
                f32x16 sA0, sA1, sB0, sB1;
#pragma unroll
                for (int q = 0; q < 16; ++q) { sA0[q] = 0.f; sA1[q] = 0.f; sB0[q] = 0.f; sB1[q] = 0.f; }
#pragma unroll
                for (int kk = 0; kk < 4; ++kk) {
                    const bf16x8 kf = *(const LAS bf16x8*)(kb_ + kk * 32);
                    const bf16x8 q0 = *(const LAS bf16x8*)(qa_ + kk * 32), q1 = *(const LAS bf16x8*)(qa_ + 32 * 144 + kk * 32);
                    sA0 = __builtin_amdgcn_mfma_f32_32x32x16_bf16(kf, q0, sA0, 0, 0, 0);
                    sA1 = __builtin_amdgcn_mfma_f32_32x32x16_bf16(kf, q1, sA1, 0, 0, 0);
                }
#pragma unroll
                for (int kk = 0; kk < 4; ++kk) {
                    const bf16x8 kf = *(const LAS bf16x8*)(kb_ + 32 * 272 + kk * 32);
                    const bf16x8 q0 = *(const LAS bf16x8*)(qa_ + kk * 32), q1 = *(const LAS bf16x8*)(qa_ + 32 * 144 + kk * 32);
                    sB0 = __builtin_amdgcn_mfma_f32_32x32x16_bf16(kf, q0, sB0, 0, 0, 0);
                    sB1 = __builtin_amdgcn_mfma_f32_32x32x16_bf16(kf, q1, sB1, 0, 0, 0);
                }
                bf16x8 pA[2][2], pB[2][2];
                SOFTMAX_STEP(sA0, lsum[0], pA[0]);
                SOFTMAX_STEP(sA1, lsum[1], pA[1]);
#pragma unroll
                for (int s = 0; s < 2; ++s) {
                    if (s == 1 && it + 1 < NKT) ATT_STAGE(cur ^ 1, it + 1);
#pragma unroll
                    for (int mt = 0; mt < 4; ++mt) {
                        const bf16x8 vf = *(const LAS bf16x8*)(vb_ + mt * (32 * 144) + (2 * s) * 16);
                        O[0][mt] = __builtin_amdgcn_mfma_f32_32x32x16_bf16(vf, pA[0][s], O[0][mt], 0, 0, 0);
                        O[1][mt] = __builtin_amdgcn_mfma_f32_32x32x16_bf16(vf, pA[1][s], O[1][mt], 0, 0, 0);
                    }
                }
                SOFTMAX_STEP(sB0, lsum[0], pB[0]);
                SOFTMAX_STEP(sB1, lsum[1], pB[1]);
#pragma unroll
                for (int s = 0; s < 2; ++s)
#pragma unroll
                    for (int mt = 0; mt < 4; ++mt) {
                        const bf16x8 vf = *(const LAS bf16x8*)(vb_ + mt * (32 * 144) + (4 + 2 * s) * 16);
                        O[0][mt] = __builtin_amdgcn_mfma_f32_32x32x16_bf16(vf, pB[0][s], O[0][mt], 0, 0, 0);
                        O[1][mt] = __builtin_amdgcn_mfma_f32_32x32x16_bf16(vf, pB[1][s], O[1][mt], 0, 0, 0);
                    }
                asm volatile("s_waitcnt vmcnt(0)" ::: "memory"); ATT_BAR();
            }
            const int lane2 = opq(lane_id()), hh2 = lane2 >> 5, l31b = lane2 & 31;
            lsum[0] += __shfl_xor(lsum[0], 32); lsum[1] += __shfl_xor(lsum[1], 32);
            LAS float* xb = (LAS float*)(lds + rg * 32768) + lane2;
            if (comp == 1) {
                const float lam = LAMP[0];
#pragma unroll
                for (int qs = 0; qs < 2; ++qs) { const float sc = lam * frcp(lsum[qs]);
#pragma unroll
                    for (int mt = 0; mt < 4; ++mt)
#pragma unroll
                        for (int q = 0; q < 16; ++q) xb[((qs * 4 + mt) * 16 + q) * 64] = O[qs][mt][q] * sc; }
            }
            __syncthreads();
            if (comp == 0) {
#pragma unroll
                for (int qs = 0; qs < 2; ++qs) {
                    const float i0 = frcp(lsum[qs]); float ss = 0.f;
#pragma unroll
                    for (int mt = 0; mt < 4; ++mt)
#pragma unroll
                        for (int q = 0; q < 16; ++q) { const float o = O[qs][mt][q] * i0 - xb[((qs * 4 + mt) * 16 + q) * 64]; O[qs][mt][q] = o; ss += o * o; }
                    ss += __shfl_xor(ss, 32);
                    const float rstd = rsqrtf(ss * (1.f / 128.f) + EPS) * 0.8f;
                    bf16_t* op = QB + (row0 + 32 * qs + l31b) * D + h * 128 + 4 * hh2;
#pragma unroll
                    for (int mt = 0; mt < 4; ++mt)
#pragma unroll
                        for (int q4 = 0; q4 < 4; ++q4) {
                            const f32x4 sg = *(const f32x4*)(a.in[17] + 32 * mt + 8 * q4 + 4 * hh2);
                            u32x2 w; w.x = pk2(O[qs][mt][4 * q4] * rstd * sg[0], O[qs][mt][4 * q4 + 1] * rstd * sg[1]); w.y = pk2(O[qs][mt][4 * q4 + 2] * rstd * sg[2], O[qs][mt][4 * q4 + 3] * rstd * sg[3]);
                            *(u32x2*)(op + 32 * mt + 8 * q4) = w;
                        }
                }
            }
            __syncthreads();
        }
    }
    GSYNC(6);
    }

#define BSYNC() do { asm volatile("s_waitcnt vmcnt(0) lgkmcnt(0)" ::: "memory"); __syncthreads(); \
        if (wave == 0) { __builtin_amdgcn_fence(__ATOMIC_ACQUIRE, "agent"); asm volatile("s_waitcnt vmcnt(0) lgkmcnt(0)" ::: "memory"); } __syncthreads(); } while (0)
    PH(7) {
        for (int pm = cb; pm < TX / 256; pm += G) {
            {
                const int tid = wave * 64 + opq(lane_id());
                for (int i = tid; i < 256 * 64; i += 512) {
                    const size_t tok = (size_t)pm * 256 + (i >> 6); const int j = i & 63, ch0 = 8 * j, g = j >> 1, c0 = 8 * (j & 1);
                    const int b = (int)(tok >> 12), t = (int)(tok & (SEQ - 1));
                    const u32x4 y0 = *(const u32x4*)(YB + tok * 512 + ch0), y1 = *(const u32x4*)(YB + ((size_t)TX + tok) * 512 + ch0);
                    const u32x4 uu = *(const u32x4*)(UG + ((size_t)(b * 32 + g) * LK + LC + t) * 16 + c0);
                    const f32x4 d0 = *(const f32x4*)(a.in[25] + ch0), d1 = *(const f32x4*)(a.in[25] + ch0 + 4);
                    u32x4 w;
                    w.x = pk2(gelu_tanh(bflo(y0.x) + bflo(y1.x) + d0[0] * bflo(uu.x)), gelu_tanh(bfhi(y0.x) + bfhi(y1.x) + d0[1] * bfhi(uu.x)));
                    w.y = pk2(gelu_tanh(bflo(y0.y) + bflo(y1.y) + d0[2] * bflo(uu.y)), gelu_tanh(bfhi(y0.y) + bfhi(y1.y) + d0[3] * bfhi(uu.y)));
                    w.z = pk2(gelu_tanh(bflo(y0.z) + bflo(y1.z) + d1[0] * bflo(uu.z)), gelu_tanh(bfhi(y0.z) + bfhi(y1.z) + d1[1] * bfhi(uu.z)));
                    w.w = pk2(gelu_tanh(bflo(y0.w) + bflo(y1.w) + d1[2] * bflo(uu.w)), gelu_tanh(bfhi(y0.w) + bfhi(y1.w) + d1[3] * bfhi(uu.w)));
                    *(u32x4*)(YG + tok * 512 + ch0) = w;
                }
            }
            BSYNC();
            { pg8::SegOrder S; S.init(0, 1, pm, 1, 0, 2, 1, 0); pg8::Gemm g{YG, WGLU, 512}; EpiGlu E{YG, SX, a.in[27]}; pg8::gemm_phase<EpiGlu, false>(lds, g, S, E, wave); }
            BSYNC();
            { pg8::SegOrder S; S.init(0, 1, pm, 1, 0, 4, 1, 0); pg8::Gemm g{SX, WPS, 512}; EpiMerge<false> E{GS, MBUF}; pg8::gemm_phase<EpiMerge<false>, false>(lds, g, S, E, wave); }
            BSYNC();
            { pg8::SegOrder S; S.init(0, 1, pm, 1, 0, 4, 1, 0); pg8::Gemm g{QB, WPA, D}; EpiMerge<true> E{GA, MBUF}; pg8::gemm_phase<EpiMerge<true>, false>(lds, g, S, E, wave); }
            BSYNC();
            { pg8::SegOrder S; S.init(0, 1, pm, 1, 0, 4, 1, 0); pg8::Gemm g{MBUF, WOUT, D}; EpiResid E{X1, X1, X1, MOD + 5 * D, 1.0f}; pg8::gemm_phase<EpiResid, false>(lds, g, S, E, wave); }
            BSYNC();
            {
                const int lane = opq(lane_id()); const int mb = pm >> 4;
                f32x4 ga[4], sh[4];
#pragma unroll
                for (int j = 0; j < 4; ++j) { const int c = 4 * lane + 256 * j;
                    const f32x4 g4 = *(const f32x4*)(a.in[31] + c), sc4 = *(const f32x4*)(MOD + (size_t)mb * NMODC + 7 * D + c);
                    ga[j] = g4 * (sc4 + 1.0f); sh[j] = *(const f32x4*)(MOD + (size_t)mb * NMODC + 6 * D + c); }
                for (int rr = wave; rr < 256; rr += 8) {
                    const size_t r = (size_t)pm * 256 + rr;
                    const float* xr = X1 + r * D;
                    f32x4 v[4]; float s2 = 0.f;
#pragma unroll
                    for (int j = 0; j < 4; ++j) { v[j] = *(const f32x4*)(xr + 4 * lane + 256 * j); s2 += (v[j][0] * v[j][0] + v[j][1] * v[j][1]) + (v[j][2] * v[j][2] + v[j][3] * v[j][3]); }
                    const float rstd = rsqrtf(wave_sum(s2) * (1.f / D) + EPS);
#pragma unroll
                    for (int j = 0; j < 4; ++j) { const f32x4 y = v[j] * rstd * ga[j] + sh[j]; u32x2 w; w.x = pk2(y[0], y[1]); w.y = pk2(y[2], y[3]);
                        *(u32x2*)(GA + r * D + 4 * lane + 256 * j) = w; }
                }
            }
            if (pm + G < TX / 256) BSYNC();
        }
    }
    GSYNC(7);
#pragma unroll 1
    for (int rg = 0; rg < REPG; ++rg)
    PH(13) { pg8::SegOrder S; S.init(256, 22, 0, 0, 0, 1, G, cb); pg8::Gemm g{GA, W13_2, D}; EpiSwiglu E{ACT}; pg8::gemm_phase<EpiSwiglu, false>(lds, g, S, E, wave); }
    GSYNC(13);
    PH(14) { pg8::SegOrder S; S.init(256, 4, 0, 0, 0, 1, G, cb); pg8::Gemm g{ACT, W2_2, DFF}; EpiResid E{X1, X1, a.out, MOD + 8 * D, 0.5f}; pg8::gemm_phase<EpiResid, false>(lds, g, S, E, wave); }
}

extern "C" void kernel_launch(void* const* d_in, const int* in_sizes, int n_in, void* d_out, int out_size, void* d_ws, size_t ws_size, hipStream_t stream) {
    static int grid = 0;
    if (grid == 0) {
        if (n_in != 34 || out_size != TX * D || ws_size < WS_END) { fprintf(stderr, "kernel_launch: unexpected shapes (n_in %d, out %d, ws %zu < %zu)\n", n_in, out_size, ws_size, (size_t)WS_END); grid = -1; return; }
        int dev = 0, cus = 0, per_cu = 0;
        hipGetDevice(&dev); hipDeviceGetAttribute(&cus, hipDeviceAttributeMultiprocessorCount, dev);
        if (hipFuncSetAttribute((const void*)mega, hipFuncAttributeMaxDynamicSharedMemorySize, LDS_BYTES) != hipSuccess) { fprintf(stderr, "kernel_launch: hipFuncSetAttribute failed\n"); grid = -1; return; }
        if (hipOccupancyMaxActiveBlocksPerMultiprocessor(&per_cu, (const void*)mega, 512, LDS_BYTES) != hipSuccess || per_cu < 1) { fprintf(stderr, "kernel_launch: occupancy query says %d\n", per_cu); per_cu = 1; }
        (void)hipGetLastError();
        grid = cus;
    }
    if (grid < 0) return;
    Args a{};
    for (int i = 0; i < 34; ++i) a.in[i] = (const float*)d_in[i];
    a.out = (float*)d_out; a.ws = (unsigned char*)d_ws;
#if MK_SPLIT
    for (int p = 0; p < NPHASE; ++p) { a.ph_lo = p; a.ph_hi = p + 1; hipLaunchKernelGGL(mega, dim3(grid), dim3(512), LDS_BYTES, stream, a); }
#else
    a.ph_lo = 0; a.ph_hi = NPHASE;
    if (hipMemsetAsync((unsigned char*)d_ws + WS_BAR, 0, 256, stream) != hipSuccess) { fprintf(stderr, "kernel_launch: memset of the barrier word failed\n"); return; }
    void* args[] = {&a};
    hipError_t e = hipLaunchCooperativeKernel((const void*)mega, dim3(grid), dim3(512), args, LDS_BYTES, stream);
    if (e != hipSuccess) fprintf(stderr, "cooperative launch failed: %s (grid %d)\n", hipGetErrorString(e), grid);
#endif
}
```
